# Optimizing an MI355X kernel written in HIP

```python
import jax, jax.numpy as jnp
from jax import lax
import numpy as np

D_MODEL = 1024
BATCH = 32
SEQ = 2048
DEPTH = 2
DEC_BATCH = 1
DEC_SEQ = 16384
PAST_LEN = 128

N_FOURIER_GROUPS = 4
FOURIER_GROUP_DIM = D_MODEL // 8
FOURIER_WIDTH = N_FOURIER_GROUPS * FOURIER_GROUP_DIM
N_HEADS = 8
QK_NOPE_DIM = 64
QK_ROPE_DIM = 32
QK_HEAD_DIM = QK_NOPE_DIM + QK_ROPE_DIM
V_HEAD_DIM = 64
ATTN_WIDTH = N_HEADS * V_HEAD_DIM
Q_LORA_RANK = D_MODEL // 4
KV_LORA_RANK = D_MODEL // 8
ROPE_THETA = 10000.0
Q_BLOCK = 128
D_FF = 4 * D_MODEL
NORM_EPS = 1e-6
OFF_F = 0
OFF_Q = OFF_F + FOURIER_WIDTH
OFF_KV = OFF_Q + Q_LORA_RANK
OFF_KR = OFF_KV + KV_LORA_RANK
OFF_GF = OFF_KR + QK_ROPE_DIM
OFF_GA = OFF_GF + D_MODEL
IN_WIDTH = OFF_GA + D_MODEL

kernel_name = "hybrid_fnet_mla_gated_encoder"


def rmsnorm(x, g):
    xf = x.astype(jnp.float32)
    xf = xf * lax.rsqrt(jnp.mean(xf * xf, axis=-1, keepdims=True) + NORM_EPS)
    return (xf * g.astype(jnp.float32)).astype(x.dtype)


def rope_tail(x, cos, sin):
    x_nope, x_rope = x[..., :QK_NOPE_DIM], x[..., QK_NOPE_DIM:]
    x1, x2 = x_rope[..., :QK_ROPE_DIM // 2], x_rope[..., QK_ROPE_DIM // 2:]
    c = cos[None, :, None, :].astype(x.dtype)
    s = sin[None, :, None, :].astype(x.dtype)
    rot = jnp.concatenate([x1 * c - x2 * s, x2 * c + x1 * s], axis=-1)
    return jnp.concatenate([x_nope, rot], axis=-1)


def fourier_mix(u):
    B, S, _ = u.shape
    ug = u.reshape(B, S, N_FOURIER_GROUPS, FOURIER_GROUP_DIM).astype(jnp.float32)
    f = jnp.fft.fft2(ug, axes=(1, 3), norm="ortho").real
    return f.reshape(B, S, FOURIER_WIDTH).astype(u.dtype)


def block_attention(q, k, v):
    B, S, H, Dh = q.shape
    nb = S // Q_BLOCK
    scale = 1.0 / np.sqrt(QK_HEAD_DIM).astype(np.float32)
    qb = q.reshape(B, nb, Q_BLOCK, H, Dh).transpose(1, 0, 2, 3, 4)

    def one_block(qblk):
        s = jnp.einsum('bqhd,bkhd->bhqk', qblk, k, preferred_element_type=jnp.float32) * scale
        p = jax.nn.softmax(s, axis=-1)
        return jnp.einsum('bhqk,bkhd->bqhd', p.astype(v.dtype), v)

    o = lax.map(one_block, qb)
    return o.transpose(1, 0, 2, 3, 4).reshape(B, S, H * V_HEAD_DIM)


def encoder_layer(x, norm1_g, w_in, q_a_norm_g, w_uq, kv_a_norm_g, w_ukv, q_norm_g, k_norm_g,
                  w_o_fourier, w_o_attn, w_out, norm2_g, w_up, w_down):
    B, S, _ = x.shape
    xn = rmsnorm(x, norm1_g)
    z = xn @ w_in
    u_f = z[..., OFF_F:OFF_Q]
    c_q = z[..., OFF_Q:OFF_KV]
    c_kv = z[..., OFF_KV:OFF_KR]
    k_r = z[..., OFF_KR:OFF_GF]
    g_f = jax.nn.sigmoid(z[..., OFF_GF:OFF_GA])
    g_a = jax.nn.sigmoid(z[..., OFF_GA:])

    y_f = fourier_mix(u_f) @ w_o_fourier

    q = (rmsnorm(c_q, q_a_norm_g) @ w_uq).reshape(B, S, N_HEADS, QK_HEAD_DIM)
    kv = (rmsnorm(c_kv, kv_a_norm_g) @ w_ukv).reshape(B, S, N_HEADS, QK_NOPE_DIM + V_HEAD_DIM)
    k_nope, v = kv[..., :QK_NOPE_DIM], kv[..., QK_NOPE_DIM:]
    k_rope = jnp.broadcast_to(k_r[:, :, None, :], (B, S, N_HEADS, QK_ROPE_DIM))
    k = jnp.concatenate([k_nope, k_rope], axis=-1)
    q = rmsnorm(q, q_norm_g)
    k = rmsnorm(k, k_norm_g)
    pos = jnp.arange(S, dtype=jnp.float32)
    inv_freq = ROPE_THETA ** (-jnp.arange(0, QK_ROPE_DIM, 2, dtype=jnp.float32) / QK_ROPE_DIM)
    ang = pos[:, None] * inv_freq[None, :]
    cos, sin = jnp.cos(ang), jnp.sin(ang)
    q = rope_tail(q, cos, sin)
    k = rope_tail(k, cos, sin)
    y_a = block_attention(q, k, v) @ w_o_attn

    h = x + (g_f * y_f + g_a * y_a) @ w_out

    hn = rmsnorm(h, norm2_g)
    return h + jnp.square(jax.nn.relu(hn @ w_up)) @ w_down


def setup_inputs(seed: int = 0) -> dict:
    key = jax.random.key(seed)
    ks = jax.random.split(key, 16)
    f32 = jnp.float32

    def w(k, shape, fan_in):
        return jax.random.normal(k, shape, f32) * (fan_in ** -0.5)

    def gain(k, n):
        return 1.0 + 0.05 * jax.random.normal(k, (DEPTH, n), f32)

    return {
        "x_prompt": jax.random.normal(ks[0], (BATCH, SEQ, D_MODEL), f32),
        "x_sample": jax.random.normal(ks[1], (DEC_BATCH, DEC_SEQ, D_MODEL), f32),
        "norm1_g": gain(ks[2], D_MODEL),
        "w_in": w(ks[3], (DEPTH, D_MODEL, IN_WIDTH), D_MODEL),
        "q_a_norm_g": gain(ks[4], Q_LORA_RANK),
        "w_uq": w(ks[5], (DEPTH, Q_LORA_RANK, N_HEADS * QK_HEAD_DIM), Q_LORA_RANK),
        "kv_a_norm_g": gain(ks[6], KV_LORA_RANK),
        "w_ukv": w(ks[7], (DEPTH, KV_LORA_RANK, N_HEADS * (QK_NOPE_DIM + V_HEAD_DIM)), KV_LORA_RANK),
        "q_norm_g": gain(ks[8], QK_HEAD_DIM),
        "k_norm_g": gain(ks[9], QK_HEAD_DIM),
        "w_o_fourier": w(ks[10], (DEPTH, FOURIER_WIDTH, D_MODEL), FOURIER_WIDTH),
        "w_o_attn": w(ks[11], (DEPTH, ATTN_WIDTH, D_MODEL), ATTN_WIDTH),
        "w_out": w(ks[12], (DEPTH, D_MODEL, D_MODEL), D_MODEL),
        "norm2_g": gain(ks[13], D_MODEL),
        "w_up": w(ks[14], (DEPTH, D_MODEL, D_FF), D_MODEL),
        "w_down": w(ks[15], (DEPTH, D_FF, D_MODEL), D_FF),
    }


def reference(x_prompt, x_sample, norm1_g, w_in, q_a_norm_g, w_uq, kv_a_norm_g, w_ukv,
              q_norm_g, k_norm_g, w_o_fourier, w_o_attn, w_out, norm2_g, w_up, w_down):
    y_prompt = x_prompt
    y_sample = x_sample
    for l in range(DEPTH):
        params = (norm1_g[l], w_in[l], q_a_norm_g[l], w_uq[l], kv_a_norm_g[l], w_ukv[l],
                  q_norm_g[l], k_norm_g[l], w_o_fourier[l], w_o_attn[l], w_out[l],
                  norm2_g[l], w_up[l], w_down[l])
        y_prompt = encoder_layer(y_prompt, *params)
        y_sample = encoder_layer(y_sample, *params)
    return (y_prompt, y_sample)
```

```cpp
#include <hip/hip_runtime.h>
#include <hip/hip_cooperative_groups.h>
#include <cstdio>
#include <cstdint>
namespace cg = cooperative_groups;
__device__ __forceinline__ int lbid() { int b = blockIdx.x; asm volatile("" : "+s"(b)); return b; }
__device__ __forceinline__ int lgdim() { int g = gridDim.x; asm volatile("" : "+s"(g)); return g; }
__device__ __forceinline__ int ltid(int wv) { int t = (wv << 6) | (int)__builtin_amdgcn_mbcnt_hi(~0u, __builtin_amdgcn_mbcnt_lo(~0u, 0u)); asm volatile("" : "+v"(t)); return t; }
namespace pg8 {
#define PG8_LAS __attribute__((address_space(3)))
typedef unsigned short bf16_t;
typedef short bf16x8 __attribute__((ext_vector_type(8)));
typedef float f32x4 __attribute__((ext_vector_type(4)));
typedef unsigned u32x4 __attribute__((ext_vector_type(4)));
constexpr int BM = 256, BK = 64, HALF = 128, HTB = HALF * BK * 2  , STAGE_BYTES = 8 * HTB, NXCD = 8, WGM = 8;

__host__ __device__ __forceinline__ int lds_byte(int r, int c) { const int st = (r >> 4) * 2 + (c >> 5), rr = r & 15, cc = c & 31, ob = rr * 64 + cc * 2; return st * 1024 + (ob ^ (((ob >> 9) & 1) << 5)); }
__host__ __device__ __forceinline__ void stage_rc(int b, int& R, int& C) { const int st = b / 1024, sb = b % 1024, swz = sb ^ (((sb >> 9) & 1) << 5); R = (st >> 1) * 16 + swz / 64; C = (st & 1) * 32 + (swz % 64) / 2; }
__host__ __device__ __forceinline__ int perm32(int rho) { const int n = rho >> 4, i = rho & 15; return 8 * (i >> 2) + 4 * n + (i & 3); }

struct Unit { int pm, pn; };
struct Gemm { const bf16_t* A; const bf16_t* Bt; int M, N, K, lda, ldb; };

struct StaticOrder {
    int nM, nN, nwg, G, c;
    __host__ __device__ void init(int M, int N, int G_, int c_) { nM = M / BM; nN = N / BM; nwg = nM * nN; G = G_; c = c_; }
    __host__ __device__ bool next(int i, Unit& u) const {
        const long L = (long)i * G + c; if (L >= nwg) return false;
        int wgid = (int)L; { const int q = nwg / NXCD, r = nwg % NXCD, xcd = wgid % NXCD, off = wgid / NXCD; wgid = (xcd < r ? xcd * (q + 1) : r * (q + 1) + (xcd - r) * q) + off; }
        const int nig = WGM * nN, gid = wgid / nig, fm = gid * WGM, gsz = (nM - fm) < WGM ? (nM - fm) : WGM;
        u.pm = fm + ((wgid % nig) % gsz); u.pn = (wgid % nig) / gsz; return true;
    }
    __device__ __forceinline__ void a_ready(const Unit&) const {}
    __device__ __forceinline__ void done(const Unit&) const {}
};


template <class Epi, class Sched, bool ALIGN_EPI = false, bool SP2 = false>
__device__ __forceinline__ void gemm_phase(PG8_LAS unsigned char* lds, const Gemm g, const Sched& S, const Epi& E, const int wv) {
    const int tid = ltid(wv), wid = __builtin_amdgcn_readfirstlane(tid >> 6), lane = tid & 63, wr = wid >> 2, wc = wid & 3, fr = lane & 15, fq = lane >> 4;
    const int K = g.K, nt = K / BK;
    unsigned voffA[2], voffB[2];
#pragma unroll
    for (int i = 0; i < 2; ++i) { int R, C; stage_rc(tid * 16 + i * 8192, R, C); const int Rb = Epi::PERM ? ((R & ~31) + perm32(R & 31)) : R;
        voffA[i] = (unsigned)(R * g.lda + C) * 2u; voffB[i] = (unsigned)(Rb * g.ldb + C) * 2u; }
    const size_t kstep = (size_t)(BK * 2);
    const size_t hstepA = (size_t)HALF * g.lda * 2, hstepB = (size_t)HALF * g.ldb * 2;
    const size_t tstepA = 2 * hstepA, tstepB = 2 * hstepB;
    const unsigned ldsw = (unsigned)wid * 1024u;
    const int aoff = lds_byte(wr * 64 + fr, fq * 8), boff = lds_byte(wc * 32 + fr, fq * 8);
#define PG8_SA(b, h) (((b) * 2 + (h)) * HTB)
#define PG8_SB(b, h) ((4 + (b) * 2 + (h)) * HTB)
#define PG8_STAGE(bufoff, gbase, voff) do { _Pragma("unroll") for (int _i = 0; _i < 2; ++_i) \
        __builtin_amdgcn_global_load_lds((const unsigned*)((const char*)(gbase) + (voff)[_i]), (PG8_LAS unsigned*)(lds + (bufoff) + ldsw + _i * 8192), 16, 0, 0); } while (0)
#define PG8_LDA(dst, b, h) do { _Pragma("unroll") for (int m = 0; m < 4; ++m) _Pragma("unroll") for (int k = 0; k < 2; ++k) dst[m][k] = *(const PG8_LAS bf16x8*)(lds + PG8_SA(b, h) + aoff + m * 2048 + k * 1024); } while (0)
#define PG8_LDB(dst, b, h) do { _Pragma("unroll") for (int n = 0; n < 2; ++n) _Pragma("unroll") for (int k = 0; k < 2; ++k) dst[n][k] = *(const PG8_LAS bf16x8*)(lds + PG8_SB(b, h) + boff + n * 2048 + k * 1024); } while (0)
#define PG8_MMA(ai, bj, At, Bt) do { __builtin_amdgcn_s_setprio(1); _Pragma("unroll") for (int m = 0; m < 4; ++m) _Pragma("unroll") for (int n = 0; n < 2; ++n) _Pragma("unroll") for (int k = 0; k < 2; ++k) \
        acc[ai][bj][m][n] = __builtin_amdgcn_mfma_f32_16x16x32_bf16(Bt[n][k], At[m][k], acc[ai][bj][m][n], 0, 0, 0); __builtin_amdgcn_s_setprio(0); } while (0)
#define PG8_WAIT_V(n) asm volatile("s_waitcnt vmcnt(" #n ")" ::: "memory")
#define PG8_WAIT_L(n) asm volatile("s_waitcnt lgkmcnt(" #n ")" ::: "memory")
#define PG8_BAR __builtin_amdgcn_s_barrier()
#define PG8_SCHED __builtin_amdgcn_sched_barrier(0)
    Unit cur, nxt; int ui = 0;
    if (!S.next(0, cur)) return;
    f32x4 acc[2][2][4][2];
#pragma unroll
    for (int a = 0; a < 2; ++a)
#pragma unroll
        for (int b = 0; b < 2; ++b)
#pragma unroll
            for (int m = 0; m < 4; ++m)
#pragma unroll
                for (int n = 0; n < 2; ++n) acc[a][b][m][n] = (f32x4){0.f, 0.f, 0.f, 0.f};
    bf16x8 At[4][2], B0[2][2], B1[2][2];
    const char* cA = (const char*)g.A + (size_t)cur.pm * tstepA; const char* cB = (const char*)g.Bt + (size_t)cur.pn * tstepB;
    S.a_ready(cur);
    if constexpr (SP2) {
        PG8_STAGE(PG8_SB(0, 0), cB, voffB); PG8_STAGE(PG8_SB(0, 1), cB + hstepB, voffB); PG8_STAGE(PG8_SA(0, 0), cA, voffA); PG8_STAGE(PG8_SA(0, 1), cA + hstepA, voffA);
        if (wr == 1) PG8_BAR;
        PG8_WAIT_V(2); PG8_BAR;
        PG8_STAGE(PG8_SB(1, 0), cB + kstep, voffB); PG8_STAGE(PG8_SA(1, 0), cA + kstep, voffA); PG8_STAGE(PG8_SB(1, 1), cB + hstepB + kstep, voffB);
        PG8_WAIT_V(6); PG8_BAR;
    } else {
        PG8_STAGE(PG8_SB(0, 0), cB, voffB); PG8_STAGE(PG8_SA(0, 0), cA, voffA); PG8_STAGE(PG8_SB(0, 1), cB + hstepB, voffB); PG8_STAGE(PG8_SA(0, 1), cA + hstepA, voffA);
        if (wr == 1) PG8_BAR;
        PG8_WAIT_V(4); PG8_BAR;
        PG8_STAGE(PG8_SB(1, 0), cB + kstep, voffB); PG8_STAGE(PG8_SA(1, 0), cA + kstep, voffA); PG8_STAGE(PG8_SB(1, 1), cB + hstepB + kstep, voffB);
        PG8_WAIT_V(6); PG8_BAR;
    }
    for (;;) {
        const bool has_next = S.next(ui + 1, nxt);
        const char* nA = has_next ? (const char*)g.A + (size_t)nxt.pm * tstepA : cA; const char* nB = has_next ? (const char*)g.Bt + (size_t)nxt.pn * tstepB : cB;
        for (int t = 0; t < nt; t += 2) {
            const bool last = (t == nt - 2);
            const char* a1 = cA + (size_t)(t + 1) * kstep;
            const char* a2 = last ? nA : cA + (size_t)(t + 2) * kstep; const char* b2 = last ? nB : cB + (size_t)(t + 2) * kstep;
            const char* a3 = a2 + kstep; const char* b3 = b2 + kstep;
            if (last && has_next) S.a_ready(nxt);
            if constexpr (SP2) {
            PG8_LDB(B0, 0, 0); PG8_LDB(B1, 0, 1); PG8_SCHED; PG8_LDA(At, 0, 0); PG8_STAGE(PG8_SA(1, 1), a1 + hstepA, voffA);
            PG8_WAIT_V(8); PG8_WAIT_L(0); PG8_BAR; PG8_MMA(0, 0, At, B0); PG8_MMA(0, 1, At, B1); PG8_BAR; PG8_SCHED;
            PG8_LDA(At, 0, 1); PG8_STAGE(PG8_SB(0, 0), b2, voffB); PG8_STAGE(PG8_SB(0, 1), b2 + hstepB, voffB); PG8_STAGE(PG8_SA(0, 0), a2, voffA);
            PG8_WAIT_V(8); PG8_WAIT_L(0); PG8_BAR; PG8_MMA(1, 0, At, B0); PG8_MMA(1, 1, At, B1); PG8_BAR; PG8_SCHED;
            PG8_LDB(B0, 1, 0); PG8_LDB(B1, 1, 1); PG8_SCHED; PG8_LDA(At, 1, 0); PG8_STAGE(PG8_SA(0, 1), a2 + hstepA, voffA);
            PG8_WAIT_V(8); PG8_WAIT_L(0); PG8_BAR; PG8_MMA(0, 0, At, B0); PG8_MMA(0, 1, At, B1); PG8_BAR; PG8_SCHED;
            PG8_LDA(At, 1, 1); PG8_STAGE(PG8_SB(1, 0), b3, voffB); PG8_STAGE(PG8_SB(1, 1), b3 + hstepB, voffB); PG8_STAGE(PG8_SA(1, 0), a3, voffA);
            PG8_WAIT_V(8); PG8_WAIT_L(0); PG8_BAR; PG8_MMA(1, 0, At, B0); PG8_MMA(1, 1, At, B1); PG8_BAR; PG8_SCHED;
            } else {
            PG8_LDB(B0, 0, 0); PG8_SCHED; PG8_LDA(At, 0, 0); PG8_STAGE(PG8_SA(1, 1), a1 + hstepA, voffA);
            PG8_WAIT_L(8); PG8_BAR; PG8_WAIT_L(0); PG8_MMA(0, 0, At, B0); PG8_BAR; PG8_SCHED;
            PG8_LDB(B1, 0, 1); PG8_STAGE(PG8_SB(0, 0), b2, voffB);
            PG8_BAR; PG8_WAIT_L(0); PG8_MMA(0, 1, At, B1); PG8_BAR;
            PG8_LDA(At, 0, 1); PG8_STAGE(PG8_SA(0, 0), a2, voffA);
            PG8_BAR; PG8_WAIT_L(0); PG8_MMA(1, 0, At, B0); PG8_BAR; PG8_SCHED;
            PG8_STAGE(PG8_SB(0, 1), b2 + hstepB, voffB);
            PG8_WAIT_V(6); PG8_BAR; PG8_MMA(1, 1, At, B1); PG8_BAR;
            PG8_LDB(B0, 1, 0); PG8_SCHED; PG8_LDA(At, 1, 0); PG8_STAGE(PG8_SA(0, 1), a2 + hstepA, voffA);
            PG8_WAIT_L(8); PG8_BAR; PG8_WAIT_L(0); PG8_MMA(0, 0, At, B0); PG8_BAR; PG8_SCHED;
            PG8_LDB(B1, 1, 1); PG8_STAGE(PG8_SB(1, 0), b3, voffB);
            PG8_BAR; PG8_WAIT_L(0); PG8_MMA(0, 1, At, B1); PG8_BAR;
            PG8_LDA(At, 1, 1); PG8_STAGE(PG8_SA(1, 0), a3, voffA);
            PG8_BAR; PG8_WAIT_L(0); PG8_MMA(1, 0, At, B0); PG8_BAR; PG8_SCHED;
            PG8_STAGE(PG8_SB(1, 1), b3 + hstepB, voffB);
            PG8_WAIT_V(6); PG8_BAR; PG8_MMA(1, 1, At, B1); PG8_BAR;
            }
            if constexpr (Epi::MIDK) { if (t + 2 == (nt >> 1)) E.mid(acc, cur, wr, wc, fr, fq); }
        }
        if constexpr (ALIGN_EPI) { if (wr == 0) PG8_BAR; }
        if constexpr (!Epi::AFTER_DRAIN) { E(acc, cur, wr, wc, fr, fq); S.done(cur); }
        if (!has_next) break;
#pragma unroll
        for (int a = 0; a < 2; ++a)
#pragma unroll
            for (int b = 0; b < 2; ++b)
#pragma unroll
                for (int m = 0; m < 4; ++m)
#pragma unroll
                    for (int n = 0; n < 2; ++n) acc[a][b][m][n] = (f32x4){0.f, 0.f, 0.f, 0.f};
        cur = nxt; cA = nA; cB = nB; ++ui;
        if constexpr (ALIGN_EPI) { if (wr == 1) PG8_BAR; }
    }
    PG8_WAIT_V(0);
    if constexpr (!ALIGN_EPI) { if (wr == 0) PG8_BAR; }
    PG8_BAR;
    if constexpr (Epi::AFTER_DRAIN) { E.fused(acc, cur, wr, wc, fr, fq, lds, wid, lane); S.done(cur); }
#undef PG8_SA
#undef PG8_SB
#undef PG8_STAGE
#undef PG8_LDA
#undef PG8_LDB
#undef PG8_MMA
#undef PG8_WAIT_V
#undef PG8_WAIT_L
#undef PG8_BAR
#undef PG8_SCHED
}
}


#define LAS __attribute__((address_space(3)))
using pg8::bf16_t; using pg8::bf16x8; using pg8::f32x4; using pg8::u32x4; using pg8::Unit;
typedef float f32x16 __attribute__((ext_vector_type(16)));
typedef unsigned u32x2 __attribute__((ext_vector_type(2)));
typedef short s16x4 __attribute__((ext_vector_type(4)));
constexpr int DM = 1024, TP = 65536, TS = 16384, T = TP + TS;
constexpr int NH = 8, DQK = 96, DFF = 4096, INW = 2976;
constexpr float EPS = 1e-6f;
constexpr size_t MiB = (size_t)1 << 20;
constexpr size_t WS_SSQ = 0;
constexpr size_t WS_BAR = 5 * MiB + 832 * 1024;
constexpr size_t WS_ROPE = 950 * MiB;
constexpr size_t WS_M1A = 5 * MiB, WS_M1B = 5 * MiB + 65536, WS_M2A = 5 * MiB + 262144, WS_M2B = 6 * MiB;
constexpr size_t WS_W = 14 * MiB, W_LAYER = 28 * MiB;
constexpr size_t WO_IN1 = 0, WO_G = 3 * MiB, WO_UQ = 7 * MiB, WO_UKV = 7 * MiB + 393216, WO_OF = 8 * MiB, WO_OA = 9 * MiB, WO_OUT = 10 * MiB, WO_UP = 12 * MiB, WO_DN = 20 * MiB;
constexpr size_t WS_AB = 70 * MiB;
constexpr size_t WS_BIG = 230 * MiB;
constexpr size_t WS_VC = WS_BIG, WS_KVRAW = WS_BIG + 160 * MiB, WS_QB = WS_BIG + 320 * MiB, WS_KB = WS_BIG + 440 * MiB;
constexpr size_t WS_CQ = WS_BIG + 560 * MiB, WS_CKV = WS_BIG + 600 * MiB, WS_FA = WS_BIG + 560 * MiB;
constexpr size_t WS_GG = WS_BIG, WS_MB = WS_BIG + 320 * MiB, WS_UB = WS_BIG;
constexpr size_t WS_END = 952 * MiB;

typedef float f32x2_t __attribute__((ext_vector_type(2))); typedef __bf16 bf16x2_t __attribute__((ext_vector_type(2)));
__device__ __forceinline__ unsigned cvt_pk(float lo, float hi) { f32x2_t v = {lo, hi}; bf16x2_t b = __builtin_convertvector(v, bf16x2_t); return __builtin_bit_cast(unsigned, b); }
__device__ __forceinline__ float bf_lo(unsigned w) { return __uint_as_float(w << 16); }
__device__ __forceinline__ float bf_hi(unsigned w) { return __uint_as_float(w & 0xffff0000u); }
__device__ __forceinline__ u32x4 pack8(f32x4 a, f32x4 b) { u32x4 w; w.x = cvt_pk(a[0], a[1]); w.y = cvt_pk(a[2], a[3]); w.z = cvt_pk(b[0], b[1]); w.w = cvt_pk(b[2], b[3]); return w; }
__device__ __forceinline__ float sumsq8(f32x4 a, f32x4 b) { return (a[0] * a[0] + a[1] * a[1]) + (a[2] * a[2] + a[3] * a[3]) + (b[0] * b[0] + b[1] * b[1]) + (b[2] * b[2] + b[3] * b[3]); }
__device__ __forceinline__ void unpack8(u32x4 w, f32x4& a, f32x4& b) { a[0] = bf_lo(w.x); a[1] = bf_hi(w.x); a[2] = bf_lo(w.y); a[3] = bf_hi(w.y); b[0] = bf_lo(w.z); b[1] = bf_hi(w.z); b[2] = bf_lo(w.w); b[3] = bf_hi(w.w); }
typedef unsigned long long u64;
__device__ __forceinline__ float rs_of(u64 ssq, float inv_n) { return 1.0f / sqrtf(__ull2float_rn(ssq) * 2.3283064365386963e-10f * inv_n + EPS); }
__device__ __forceinline__ void ssq_add(u64* p, float s) { atomicAdd(p, __float2ull_rn(s * 4294967296.0f)); }

struct EpiIn {
    static constexpr bool PERM = true, AFTER_DRAIN = false, MIDK = false;
    bf16_t* Vc; bf16_t* CQ; bf16_t* CKV; const u64* ssq_x; u64* ssq_q; u64* ssq_kv; bf16_t* GG;
    __device__ __forceinline__ void operator()(const f32x4 (&acc)[2][2][4][2], const Unit& u, int wr, int wc, int fr, int fq) const {
        const int row0 = u.pm * 256 + wr * 64 + fr;
        if (u.pn >= 6) {
            const int col0 = (u.pn - 6) * 256 + wc * 32 + 8 * fq;
#pragma unroll
            for (int ai = 0; ai < 2; ++ai)
#pragma unroll
                for (int m = 0; m < 4; ++m) {
                    const int row = row0 + ai * 128 + m * 16;
                    const float rs = rs_of(ssq_x[row], 1.0f / 1024.0f);
                    bf16_t* rp = GG + (size_t)row * 2048 + col0;
#pragma unroll
                    for (int bj = 0; bj < 2; ++bj) { f32x4 v0 = acc[ai][bj][m][0] * rs, v1 = acc[ai][bj][m][1] * rs;
#pragma unroll
                        for (int e = 0; e < 4; ++e) { v0[e] = __builtin_amdgcn_rcpf(1.0f + __expf(-v0[e])); v1[e] = __builtin_amdgcn_rcpf(1.0f + __expf(-v1[e])); }
                        *(u32x4*)(rp + bj * 128) = pack8(v0, v1); }
                }
            return;
        }
        bf16_t* base; int ldc, colt; u64* ssq;
        if (u.pn < 4) { base = Vc; ldc = 1024; colt = u.pn * 256; ssq = nullptr; }
        else if (u.pn == 4) { base = CQ; ldc = 256; colt = 0; ssq = ssq_q; }
        else { base = CKV; ldc = 256; colt = 0; ssq = ssq_kv; }
        const bool only0 = (u.pn == 5);
        const int col0 = colt + wc * 32 + 8 * fq;
#pragma unroll
        for (int ai = 0; ai < 2; ++ai)
#pragma unroll
            for (int m = 0; m < 4; ++m) {
                const int row = row0 + ai * 128 + m * 16;
                const float rs = rs_of(ssq_x[row], 1.0f / 1024.0f);
                const f32x4 a0 = acc[ai][0][m][0] * rs, a1 = acc[ai][0][m][1] * rs, b0 = acc[ai][1][m][0] * rs, b1 = acc[ai][1][m][1] * rs;
                bf16_t* rp = base + (size_t)row * ldc + col0;
                *(u32x4*)(rp) = pack8(a0, a1); *(u32x4*)(rp + 128) = pack8(b0, b1);
                if (ssq) { float s = sumsq8(a0, a1); if (!only0) s += sumsq8(b0, b1);
                    s += __shfl_xor(s, 16); s += __shfl_xor(s, 32); if (fq == 0) ssq_add(ssq + row, s); }
            }
    }
};
template <int ACT> struct EpiRowScale {
    static constexpr bool PERM = true, AFTER_DRAIN = false, MIDK = false;
    bf16_t* O; int ldc; const u64* ssq; float inv_n;
    static __device__ __forceinline__ float act(float v) {
        if (ACT == 1) return __builtin_amdgcn_rcpf(1.0f + __expf(-v));
        if (ACT == 2) { const float r = fmaxf(v, 0.f); return r * r; }
        return v; }
    __device__ __forceinline__ void operator()(const f32x4 (&acc)[2][2][4][2], const Unit& u, int wr, int wc, int fr, int fq) const {
        const int row0 = u.pm * 256 + wr * 64 + fr, col0 = u.pn * 256 + wc * 32 + 8 * fq;
#pragma unroll
        for (int ai = 0; ai < 2; ++ai)
#pragma unroll
            for (int m = 0; m < 4; ++m) {
                const int row = row0 + ai * 128 + m * 16;
                const float rs = rs_of(ssq[row], inv_n);
                bf16_t* rp = O + (size_t)row * ldc + col0;
#pragma unroll
                for (int bj = 0; bj < 2; ++bj) { f32x4 v0 = acc[ai][bj][m][0] * rs, v1 = acc[ai][bj][m][1] * rs;
#pragma unroll
                    for (int e = 0; e < 4; ++e) { v0[e] = act(v0[e]); v1[e] = act(v1[e]); }
                    *(u32x4*)(rp + bj * 128) = pack8(v0, v1); }
            }
    }
};
struct EpiMixK {
    static constexpr bool PERM = true, AFTER_DRAIN = false, MIDK = true;
    bf16_t* Mb; const bf16_t* GG;
    __device__ __forceinline__ void mid(f32x4 (&acc)[2][2][4][2], const Unit& u, int wr, int wc, int fr, int fq) const {
        const int row0 = u.pm * 256 + wr * 64 + fr, col0 = u.pn * 256 + wc * 32 + 8 * fq;
#pragma unroll
        for (int ai = 0; ai < 2; ++ai)
#pragma unroll
            for (int m = 0; m < 4; ++m) {
                const bf16_t* gp = GG + (size_t)(row0 + ai * 128 + m * 16) * 2048 + col0;
#pragma unroll
                for (int bj = 0; bj < 2; ++bj) { f32x4 f0, f1, a0, a1; unpack8(*(const u32x4*)(gp + bj * 128), f0, f1); unpack8(*(const u32x4*)(gp + 1024 + bj * 128), a0, a1);
#pragma unroll
                    for (int e = 0; e < 4; ++e) { acc[ai][bj][m][0][e] *= f0[e] * __builtin_amdgcn_rcpf(fmaxf(a0[e], 1e-30f)); acc[ai][bj][m][1][e] *= f1[e] * __builtin_amdgcn_rcpf(fmaxf(a1[e], 1e-30f)); } }
                asm volatile("" ::: "memory");
            }
    }
    __device__ __forceinline__ void operator()(const f32x4 (&acc)[2][2][4][2], const Unit& u, int wr, int wc, int fr, int fq) const {
        const int row0 = u.pm * 256 + wr * 64 + fr, col0 = u.pn * 256 + wc * 32 + 8 * fq;
#pragma unroll
        for (int ai = 0; ai < 2; ++ai)
#pragma unroll
            for (int m = 0; m < 4; ++m) {
                const int row = row0 + ai * 128 + m * 16;
                const bf16_t* gp = GG + (size_t)row * 2048 + 1024 + col0; bf16_t* mp = Mb + (size_t)row * 1024 + col0;
#pragma unroll
                for (int bj = 0; bj < 2; ++bj) { f32x4 a0, a1; unpack8(*(const u32x4*)(gp + bj * 128), a0, a1);
#pragma unroll
                    for (int e = 0; e < 4; ++e) { a0[e] = fmaxf(a0[e], 1e-30f); a1[e] = fmaxf(a1[e], 1e-30f); }
                    *(u32x4*)(mp + bj * 128) = pack8(acc[ai][bj][m][0] * a0, acc[ai][bj][m][1] * a1); }
                asm volatile("" ::: "memory");
            }
    }
};
template <bool RES_BF16, bool WR_AB, bool WR_F32> struct EpiResid {
    static constexpr bool PERM = true, AFTER_DRAIN = false, MIDK = false;
    const float* res0; const float* res1; float* out; bf16_t* ab; u64* ssq;
    __device__ __forceinline__ void operator()(const f32x4 (&acc)[2][2][4][2], const Unit& u, int wr, int wc, int fr, int fq) const {
        const int row0 = u.pm * 256 + wr * 64 + fr, col0 = u.pn * 256 + wc * 32 + 8 * fq;
        const float* rbase = (u.pm * 256 < TP) ? res0 : (res1 - (size_t)TP * 1024);
#pragma unroll
        for (int ai = 0; ai < 2; ++ai)
#pragma unroll
            for (int m = 0; m < 4; ++m) {
                const int row = row0 + ai * 128 + m * 16;
                const size_t off = (size_t)row * 1024 + col0;
                float s = 0.f;
#pragma unroll
                for (int bj = 0; bj < 2; ++bj) {
                    f32x4 r0, r1;
                    if (RES_BF16) unpack8(*(const u32x4*)(ab + off + bj * 128), r0, r1);
                    else { r0 = *(const f32x4*)(rbase + off + bj * 128); r1 = *(const f32x4*)(rbase + off + bj * 128 + 4); }
                    const f32x4 v0 = r0 + acc[ai][bj][m][0], v1 = r1 + acc[ai][bj][m][1];
                    if (WR_F32) { *(f32x4*)(out + off + bj * 128) = v0; *(f32x4*)(out + off + bj * 128 + 4) = v1; }
                    if (WR_AB) { *(u32x4*)(ab + off + bj * 128) = pack8(v0, v1); s += sumsq8(v0, v1); } }
                if (WR_AB) { if (ssq) { s += __shfl_xor(s, 16); s += __shfl_xor(s, 32); if (fq == 0) ssq_add(ssq + row, s); } }
                asm volatile("" ::: "memory");
            }
    }
};
struct Args { const float* in[16]; float* out; unsigned char* ws; int ph_lo, ph_hi; };
__device__ __forceinline__ float wave_sum(float v) {
#pragma unroll
    for (int o = 1; o < 64; o <<= 1) v += __shfl_xor(v, o);
    return v;
}
#define LDS_WAIT() asm volatile("s_waitcnt lgkmcnt(0)" ::: "memory")

__device__ __forceinline__ void tr_item(const float* __restrict__ W, int ldw, int col0, int K, const float* __restrict__ gain, bf16_t* __restrict__ WT, int ldt, int kofs, int row0, int nblk, LAS float* scr, int item, int lane) {
    const int kb = item / nblk, nb = item % nblk, k0 = 64 * kb, n0 = 32 * nb;
#pragma unroll 8
    for (int i = 0; i < 32; ++i) { const int kk = 2 * i + (lane >> 5); const float g = gain ? gain[k0 + kk] : 1.0f;
        scr[kk * 33 + (lane & 31)] = W[(size_t)(k0 + kk) * ldw + col0 + n0 + (lane & 31)] * g; }
    LDS_WAIT(); asm volatile("" ::: "memory");
    const int c = lane & 7;
#pragma unroll
    for (int j = 0; j < 4; ++j) { const int n = (lane >> 3) + 8 * j; const LAS float* s = scr + (8 * c) * 33 + n;
        u32x4 o; o.x = cvt_pk(s[0 * 33], s[1 * 33]); o.y = cvt_pk(s[2 * 33], s[3 * 33]); o.z = cvt_pk(s[4 * 33], s[5 * 33]); o.w = cvt_pk(s[6 * 33], s[7 * 33]);
        *(u32x4*)(WT + (size_t)(row0 + n0 + n) * ldt + kofs + k0 + 8 * c) = o; }
    LDS_WAIT(); asm volatile("" ::: "memory");
}
__device__ __forceinline__ void tr_piece(const float* W, int ldw, int col0, int ncols, int K, const float* gain, bf16_t* WT, int row0, LAS float* scr, int gw, int NGW, int lane, int ldt = 0, int kofs = 0) {
    const int nblk = ncols / 32, nitems = (K / 64) * nblk;
    for (int it = gw; it < nitems; it += NGW) tr_item(W, ldw, col0, K, gain, WT, ldt ? ldt : K, kofs, row0, nblk, scr, it, lane);
}

__device__ __forceinline__ void p0_prologue(const Args& a, unsigned char* lds_g, const int wv) {
    LAS unsigned char* lds = (LAS unsigned char*)lds_g;
    const int tid = ltid(wv), lane = tid & 63, wave = tid >> 6, G = lgdim();
    const int gw = lbid() * 8 + wave, NGW = G * 8, gt = lbid() * 512 + tid, NGT = G * 512;
    unsigned char* ws = a.ws;
    u64* ssq = (u64*)(ws + WS_SSQ);
    for (int i = gt + T; i < 8 * T; i += NGT) ssq[i] = 0ull;
    bf16_t* AB = (bf16_t*)(ws + WS_AB);
    for (int m = gw; m < T; m += NGW) {
        const float* xr = (m < TP) ? a.in[0] + (size_t)m * DM : a.in[1] + (size_t)(m - TP) * DM;
        f32x4 v[4]; float s = 0.f;
#pragma unroll
        for (int j = 0; j < 4; ++j) { v[j] = ((const f32x4*)xr)[lane + 64 * j]; s += (v[j][0] * v[j][0] + v[j][1] * v[j][1]) + (v[j][2] * v[j][2] + v[j][3] * v[j][3]); }
        s = wave_sum(s);
        u32x2* o8 = (u32x2*)(AB + (size_t)m * DM);
#pragma unroll
        for (int j = 0; j < 4; ++j) { u32x2 w; w.x = cvt_pk(v[j][0], v[j][1]); w.y = cvt_pk(v[j][2], v[j][3]); o8[lane + 64 * j] = w; }
        if (lane == 0) ssq[m] = __float2ull_rn(s * 4294967296.0f);
    }
    LAS float* scr = (LAS float*)(lds + wave * 16384);
    for (int l = 0; l < 2; ++l) {
        unsigned char* wl = ws + WS_W + (size_t)l * W_LAYER;
        const float* w_in = a.in[3] + (size_t)l * DM * INW; const float* g1 = a.in[2] + l * DM;
        tr_piece(w_in, INW, 512, 256, DM, g1, (bf16_t*)(wl + WO_IN1), 1024, scr, gw, NGW, lane);
        tr_piece(w_in, INW, 768, 160, DM, g1, (bf16_t*)(wl + WO_IN1), 1280, scr, gw, NGW, lane);
        tr_piece(w_in, INW, 928, 2048, DM, g1, (bf16_t*)(wl + WO_G), 0, scr, gw, NGW, lane);
        tr_piece(a.in[5] + (size_t)l * 256 * 768, 768, 0, 768, 256, a.in[4] + l * 256, (bf16_t*)(wl + WO_UQ), 0, scr, gw, NGW, lane);
        tr_piece(a.in[7] + (size_t)l * 128 * 1024, 1024, 0, 1024, 128, a.in[6] + l * 128, (bf16_t*)(wl + WO_UKV), 0, scr, gw, NGW, lane);
        tr_piece(a.in[10] + (size_t)l * 512 * 1024, 1024, 0, 1024, 512, nullptr, (bf16_t*)(wl + WO_OF), 0, scr, gw, NGW, lane, 1024, 0);
        tr_piece(a.in[11] + (size_t)l * 512 * 1024, 1024, 0, 1024, 512, nullptr, (bf16_t*)(wl + WO_OF), 0, scr, gw, NGW, lane, 1024, 512);
        tr_piece(a.in[12] + (size_t)l * 1024 * 1024, 1024, 0, 1024, 1024, nullptr, (bf16_t*)(wl + WO_OUT), 0, scr, gw, NGW, lane);
        tr_piece(a.in[14] + (size_t)l * 1024 * 4096, 4096, 0, 4096, 1024, a.in[13] + l * DM, (bf16_t*)(wl + WO_UP), 0, scr, gw, NGW, lane);
        tr_piece(a.in[15] + (size_t)l * 4096 * 1024, 1024, 0, 1024, 4096, nullptr, (bf16_t*)(wl + WO_DN), 0, scr, gw, NGW, lane);
        u32x4* z = (u32x4*)((bf16_t*)(wl + WO_IN1) + (size_t)1440 * DM);
        for (int i = gt; i < 96 * DM / 8; i += NGT) z[i] = (u32x4){0u, 0u, 0u, 0u};
    }
    {
        bf16_t* m1a = (bf16_t*)(ws + WS_M1A); bf16_t* m1b = (bf16_t*)(ws + WS_M1B); bf16_t* m2a = (bf16_t*)(ws + WS_M2A); bf16_t* m2b = (bf16_t*)(ws + WS_M2B);
        for (int i = gt; i < 64 * 64 + 256 * 256; i += NGT) {
            const bool big = i >= 64 * 64; const int j = big ? i - 64 * 64 : i; const int N1 = big ? 128 : 32, W2 = 2 * N1;
            const int r = j / W2, c = j % W2, pp = r / N1, k1 = r % N1, p = c / N1, n1 = c % N1;
            const float ang = 2.0f * (float)((n1 * k1) % N1) / (float)N1; const float cs = cospif(ang), sn = sinpif(ang);
            const float sc = big ? 0.0078125f : 0.02209708691207961f;
            const float v = (pp == p) ? cs : (pp == 0 ? sn : -sn);
            (big ? m1b : m1a)[j] = (bf16_t)(cvt_pk(v * sc, 0.f) & 0xffffu);
        }
        for (int i = gt; i < 32 * 64 * 128 + 128 * 128 * 256; i += NGT) {
            const bool big = i >= 32 * 64 * 128; const int j = big ? i - 32 * 64 * 128 : i;
            const int N1 = big ? 128 : 32, N2 = big ? 128 : 64, S = N1 * N2, W2 = 2 * N2;
            const int c = j % W2, k2 = (j / W2) % N2, k1 = j / (W2 * N2), p = c / N2, n2 = c % N2;
            const int mm = (n2 * (k1 + N1 * k2)) % S; const float ang = 2.0f * (float)mm / (float)S;
            const float v = p ? sinpif(ang) : cospif(ang);
            (big ? m2b : m2a)[j] = (bf16_t)(cvt_pk(v, 0.f) & 0xffffu);
        }
        float2* rt = (float2*)(ws + WS_ROPE);
        for (int i = gt; i < 16384 * 16; i += NGT) { const int pos = i >> 4, f = i & 15;
            const float inv = powf(10000.0f, -(float)(2 * f) / 32.0f); const float ang = (float)pos * inv; float s, c; sincosf(ang, &s, &c); rt[i] = make_float2(c, s); }
    }
    __syncthreads();
    {
        LAS float* cs = (LAS float*)lds; LAS float* sn = cs + 128; LAS float* wl_s = sn + 128;
        if (tid < 128) { cs[tid] = cospif(2.0f * (float)tid / 128.0f); sn[tid] = sinpif(2.0f * (float)tid / 128.0f); }
        for (int it = lbid(); it < 2 * 128 * 4; it += G) {
            const int l = it >> 9, db = (it >> 2) & 127, g = it & 3, d0 = db * 8;
            const float* w_in = a.in[3] + (size_t)l * DM * INW; const float* g1 = a.in[2] + l * DM;
            __syncthreads();
            for (int i = tid; i < 1024; i += 512) wl_s[i] = w_in[(size_t)(d0 + (i >> 7)) * INW + g * 128 + (i & 127)];
            __syncthreads();
            const int j = tid & 127, p = (tid >> 7) & 1, dh = tid >> 8;
            float acc0 = 0.f, acc1 = 0.f, acc2 = 0.f, acc3 = 0.f;
            for (int c = 0; c < 128; ++c) { const int idx = (c * j) & 127; const float w = p ? -sn[idx] : cs[idx];
                acc0 += wl_s[(dh * 4 + 0) * 128 + c] * w; acc1 += wl_s[(dh * 4 + 1) * 128 + c] * w; acc2 += wl_s[(dh * 4 + 2) * 128 + c] * w; acc3 += wl_s[(dh * 4 + 3) * 128 + c] * w; }
            const float sc = 0.08838834764831845f; const int dd = d0 + dh * 4;
            u32x2 o; o.x = cvt_pk(acc0 * sc * g1[dd], acc1 * sc * g1[dd + 1]); o.y = cvt_pk(acc2 * sc * g1[dd + 2], acc3 * sc * g1[dd + 3]);
            bf16_t* dst = (bf16_t*)(ws + WS_W + (size_t)l * W_LAYER + WO_IN1) + (size_t)(p * 512 + g * 128 + j) * DM + dd;
            *(u32x2*)dst = o;
        }
        __syncthreads();
    }
}

template <bool WHICH> __device__ __forceinline__ const bf16_t* fin_src(const bf16_t* Qb, const bf16_t* KV, const bf16_t* CKV, int token, int h, int pc) {
    return !WHICH ? Qb + (size_t)token * 768 + h * 96 + pc * 32 : (pc < 2 ? KV + (size_t)token * 1024 + h * 128 + pc * 32 : CKV + (size_t)token * 256 + 128);
}
__device__ __forceinline__ void fin_math(const u32x4 (&w)[4], const float (&g)[32], const float2* __restrict__ rt, int token, int part, u32x4 (&o)[4]) {
    float v[32];
#pragma unroll
    for (int j = 0; j < 4; ++j) { v[8*j] = bf_lo(w[j].x); v[8*j+1] = bf_hi(w[j].x); v[8*j+2] = bf_lo(w[j].y); v[8*j+3] = bf_hi(w[j].y); v[8*j+4] = bf_lo(w[j].z); v[8*j+5] = bf_hi(w[j].z); v[8*j+6] = bf_lo(w[j].w); v[8*j+7] = bf_hi(w[j].w); }
    float ss = 0.f;
#pragma unroll
    for (int d = 0; d < 32; ++d) ss += v[d] * v[d];
    if (part == 3) ss = 0.f;
    ss += __shfl_xor(ss, 1); ss += __shfl_xor(ss, 2);
    const float r = 1.0f / sqrtf(ss * (1.0f / 96.0f) + EPS);
#pragma unroll
    for (int d = 0; d < 32; ++d) v[d] = v[d] * r * g[d];
    if (part == 2) { const int pos = token < TP ? (token & 2047) : token - TP;
#pragma unroll
        for (int f = 0; f < 16; ++f) { const float2 cs = rt[pos * 16 + f]; const float x1 = v[f], x2 = v[16 + f]; v[f] = x1 * cs.x - x2 * cs.y; v[16 + f] = x2 * cs.x + x1 * cs.y; } }
#pragma unroll
    for (int j = 0; j < 4; ++j) { o[j].x = cvt_pk(v[8*j], v[8*j+1]); o[j].y = cvt_pk(v[8*j+2], v[8*j+3]); o[j].z = cvt_pk(v[8*j+4], v[8*j+5]); o[j].w = cvt_pk(v[8*j+6], v[8*j+7]); }
}
template <bool WHICH> __device__ __forceinline__ void finalize_pass(const Args& a, int l, const int wv) {
    unsigned char* ws = a.ws;
    bf16_t* Qb = (bf16_t*)(ws + WS_QB); bf16_t* Kb = (bf16_t*)(ws + WS_KB); const bf16_t* KV = (const bf16_t*)(ws + WS_KVRAW); const bf16_t* CKV = (const bf16_t*)(ws + WS_CKV);
    const float2* rt = (const float2*)(ws + WS_ROPE);
    const int NGT = lgdim() * 512, gt = lbid() * 512 + ltid(wv), part = gt & 3, pc = part < 3 ? part : 2;
    static_assert((T * NH * 4) % (2 * 256 * 512) == 0, "uniform trip count");
    float g[32];
    { const float* gg = (WHICH ? a.in[9] : a.in[8]) + l * DQK + pc * 32;
#pragma unroll
      for (int d = 0; d < 32; ++d) g[d] = WHICH ? gg[d] : gg[d] * 0.14724448646421766f; }
    bf16_t* dst = WHICH ? Kb : Qb;
    for (int i = gt; i < T * NH * 4; i += 2 * NGT) {
        const int t0 = (i >> 2) >> 3, h0 = (i >> 2) & 7, i1 = i + NGT, t1 = (i1 >> 2) >> 3, h1 = (i1 >> 2) & 7;
        const u32x4* s0 = (const u32x4*)fin_src<WHICH>(Qb, KV, CKV, t0, h0, pc); const u32x4* s1 = (const u32x4*)fin_src<WHICH>(Qb, KV, CKV, t1, h1, pc);
        u32x4 w0[4], w1[4], o0[4], o1[4];
#pragma unroll
        for (int j = 0; j < 4; ++j) { w0[j] = s0[j]; w1[j] = s1[j]; }
        fin_math(w0, g, rt, t0, part, o0); fin_math(w1, g, rt, t1, part, o1);
        if (part < 3) { u32x4* d0 = (u32x4*)(dst + (size_t)t0 * 768 + h0 * 96 + part * 32); u32x4* d1 = (u32x4*)(dst + (size_t)t1 * 768 + h1 * 96 + part * 32);
#pragma unroll
            for (int j = 0; j < 4; ++j) { d0[j] = o0[j]; d1[j] = o1[j]; } }
    }
}
__device__ __forceinline__ void finalize_qk(const Args& a, int l, const int wv) { finalize_pass<true>(a, l, wv); }

__device__ __forceinline__ int crow(int r, int hi) { return (r & 3) + 8 * (r >> 2) + 4 * hi; }
typedef short v4i16_t __attribute__((ext_vector_type(4)));
__device__ __forceinline__ s16x4 vtr(const LAS char* p) { return __builtin_bit_cast(s16x4, __builtin_amdgcn_ds_read_tr16_b64_v4i16((LAS v4i16_t*)p)); }
template <int KC> __device__ __forceinline__ void seqmix_load(u32x4 (&st)[KC / 32], const bf16_t* in, size_t in_stride, int tid) {
    constexpr int KH = KC / 2;
#pragma unroll
    for (int i = 0; i < KC / 32; ++i) { const int id = tid + 512 * i, row = id >> 4, ch = id & 15, p = row / KH, n = row % KH;
        st[i] = *(const u32x4*)(in + (size_t)n * in_stride + p * 512 + ch * 8); }
}
template <int MOUT, int KC, int MH, int ISTR, int OSTR, class Desc>
__device__ __forceinline__ void seqmix_run(unsigned char* lds_g, const Desc D, int first, int step, int nunits, const int wv) {
    constexpr size_t in_stride = ISTR, out_stride = OSTR;
    constexpr int PITCH = 320, NLD = KC / 32, NRB = MOUT / 32, WR = NRB < 8 ? NRB : 8, WCN = 8 / WR, CPW = 4 / WCN, NKS = KC / 16;
    LAS char* lds = (LAS char*)lds_g;
    const int tid = ltid(wv), lane = tid & 63, wid = tid >> 6, r32 = lane & 31, hi = lane >> 5;
    const int rb = wid % WR, cg0 = (wid / WR) * CPW;
    const LAS char* vb = lds + (8 * hi + ((lane >> 2) & 3)) * PITCH + (16 * ((lane >> 4) & 1) + 4 * (lane & 3)) * 2;
    u32x4 st[NLD];
    int u = first;
    if (u < nunits) { const bf16_t* mat; const bf16_t* in; bf16_t* out; D(u, mat, in, out); seqmix_load<KC>(st, in, in_stride, tid); }
    while (u < nunits) {
        const bf16_t* mat; const bf16_t* in; bf16_t* out; D(u, mat, in, out);
        bf16x8 af[NKS];
#pragma unroll
        for (int ks = 0; ks < NKS; ++ks) af[ks] = *(const bf16x8*)(mat + (size_t)(rb * 32 + r32) * KC + ks * 16 + hi * 8);
        __syncthreads();
#pragma unroll
        for (int i = 0; i < NLD; ++i) { const int id = tid + 512 * i, row = id >> 4, ch = id & 15; *(LAS u32x4*)(lds + row * PITCH + ch * 16) = st[i]; }
        __syncthreads();
        const int un = u + step;
        if (un < nunits) { const bf16_t* m2; const bf16_t* in2; bf16_t* o2; D(un, m2, in2, o2); seqmix_load<KC>(st, in2, in_stride, tid); }
        f32x16 acc[CPW];
#pragma unroll
        for (int c = 0; c < CPW; ++c) acc[c] = (f32x16){};
#pragma unroll
        for (int ks = 0; ks < NKS; ++ks)
#pragma unroll
            for (int c = 0; c < CPW; ++c) {
                const s16x4 lo = vtr(vb + ks * 16 * PITCH + (cg0 + c) * 64), h4 = vtr(vb + ks * 16 * PITCH + 4 * PITCH + (cg0 + c) * 64);
                const bf16x8 b = (bf16x8){lo[0], lo[1], lo[2], lo[3], h4[0], h4[1], h4[2], h4[3]};
                acc[c] = __builtin_amdgcn_mfma_f32_32x32x16_bf16(af[ks], b, acc[c], 0, 0, 0);
            }
        {
          LAS char* stg = lds + 81920 + wid * 2560;
#pragma unroll
          for (int c = 0; c < CPW; ++c) {
#pragma unroll
            for (int r = 0; r < 16; ++r) *(LAS unsigned short*)(stg + crow(r, hi) * 80 + r32 * 2) = (unsigned short)(cvt_pk(acc[c][r], 0.f) & 0xffffu);
            asm volatile("" ::: "memory");
#pragma unroll
            for (int j = 0; j < 2; ++j) { const int id = lane + 64 * j, row = id >> 2, ch = id & 3, m = rb * 32 + row;
              const u32x4 v = *(const LAS u32x4*)(stg + row * 80 + ch * 16);
              *(u32x4*)(out + (size_t)(m % MH) * out_stride + (m / MH) * 512 + (cg0 + c) * 32 + ch * 8) = v; }
            asm volatile("" ::: "memory");
          } }
        u = un;
    }
    __syncthreads();
}
struct DescS1S { bf16_t* VC; const bf16_t* m; __device__ __forceinline__ void operator()(int u, const bf16_t*& mat, const bf16_t*& in, bf16_t*& out) const {
    const int chunk = u & 3, n2 = u >> 2; bf16_t* p = VC + (size_t)(TP + n2) * 1024 + chunk * 128; mat = m; in = p; out = p; } };
struct DescS1P { bf16_t* VC; const bf16_t* m; __device__ __forceinline__ void operator()(int u, const bf16_t*& mat, const bf16_t*& in, bf16_t*& out) const {
    const int chunk = u & 3, n2 = (u >> 2) & 63, b = u >> 8; bf16_t* p = VC + (size_t)(b * 2048 + n2) * 1024 + chunk * 128; mat = m; in = p; out = p; } };
struct DescS2S { const bf16_t* T1; bf16_t* FA; const bf16_t* m; __device__ __forceinline__ void operator()(int u, const bf16_t*& mat, const bf16_t*& in, bf16_t*& out) const {
    const int chunk = u & 3, k1 = u >> 2; mat = m + (size_t)k1 * 128 * 256; in = T1 + (size_t)(TP + 128 * k1) * 1024 + chunk * 128; out = FA + (size_t)(TP + k1) * 1024 + chunk * 128; } };
struct DescS2P { const bf16_t* T1; bf16_t* FA; const bf16_t* m; __device__ __forceinline__ void operator()(int u, const bf16_t*& mat, const bf16_t*& in, bf16_t*& out) const {
    const int chunk = u & 3, k1 = (u >> 2) & 31, b = u >> 7; mat = m + (size_t)k1 * 64 * 128; in = T1 + (size_t)(b * 2048 + 64 * k1) * 1024 + chunk * 128; out = FA + (size_t)(b * 2048 + k1) * 1024 + chunk * 128; } };
__device__ __forceinline__ void fourier_stage1(const Args& a, unsigned char* lds, const int wv) {
    unsigned char* ws = a.ws; bf16_t* VC = (bf16_t*)(ws + WS_VC);
    seqmix_run<256, 256, 128, 128 * 1024, 128 * 1024>(lds, DescS1S{VC, (const bf16_t*)(ws + WS_M1B)}, lbid(), lgdim(), 512, wv);
    seqmix_run<64, 64, 32, 64 * 1024, 64 * 1024>(lds, DescS1P{VC, (const bf16_t*)(ws + WS_M1A)}, lbid(), lgdim(), 8192, wv);
}
__device__ __forceinline__ void fourier_stage2(const Args& a, unsigned char* lds, const int wv) {
    unsigned char* ws = a.ws; const bf16_t* T1 = (const bf16_t*)(ws + WS_VC); bf16_t* FA = (bf16_t*)(ws + WS_FA);
    seqmix_run<128, 256, 128, 1024, 128 * 1024>(lds, DescS2S{T1, FA, (const bf16_t*)(ws + WS_M2B)}, lbid(), lgdim(), 512, wv);
    seqmix_run<64, 128, 64, 1024, 32 * 1024>(lds, DescS2P{T1, FA, (const bf16_t*)(ws + WS_M2A)}, lbid(), lgdim(), 4096, wv);
}

namespace att {
constexpr int NW = 8, QBLK = 32, KVBLK = 64;
constexpr int LDQ = 768, LDK = 768, LDV = 1024, LDO = 1024;
constexpr float SCALE = 0.10206207261596575f;
constexpr float THR = 8.f;
constexpr size_t SHM_V = 64 * 128 * 2, SHM_K = 64 * 256;
#define KSWZ(row, colB) ((row) * 256 + ((colB) ^ (((row) & 7) << 4)))
#define SBAR() __builtin_amdgcn_sched_barrier(0)
#define MX3(a, b, c) __builtin_fmaxf(__builtin_fmaxf((a), (b)), (c))
template <bool FIRST> __device__ __forceinline__ void partialSM(f32x16& p0, f32x16& p1, float& m_reg, f32x16& negm, float& alpha) {
  constexpr float THR2 = THR * 1.4426950408889634f;
  float a = MX3(p0[0], p0[1], p1[0]), b = MX3(p0[2], p0[3], p1[1]); a = MX3(a, p1[2], p1[3]);
#pragma unroll
  for (int r = 4; r < 16; r += 4) { a = MX3(a, p0[r], p0[r + 1]); b = MX3(b, p0[r + 2], p0[r + 3]); a = MX3(a, p1[r], p1[r + 1]); b = MX3(b, p1[r + 2], p1[r + 3]); }
  float pmax = __builtin_fmaxf(a, b);
  { auto rr = __builtin_amdgcn_permlane32_swap(__float_as_uint(pmax), __float_as_uint(pmax), false, false);
    pmax = __builtin_fmaxf(__uint_as_float(rr[0]), __uint_as_float(rr[1])); }
  alpha = 1.f;
  if (FIRST || !__builtin_expect(__all(pmax <= THR2), 1)) {
    const float dl = FIRST ? pmax : __builtin_fmaxf(pmax, 0.f);
    m_reg += dl;
#pragma unroll
    for (int r = 0; r < 16; ++r) { p0[r] -= dl; p1[r] -= dl; }
#pragma unroll
    for (int r = 0; r < 16; ++r) negm[r] = -m_reg;
    if (!FIRST) alpha = __builtin_amdgcn_exp2f(-dl);
  }
#pragma unroll
  for (int r = 0; r < 16; ++r) p0[r] = __builtin_amdgcn_exp2f(p0[r]);
}
__device__ __forceinline__ void finishSM(f32x16& p0, f32x16& p1, float alpha, float& l_reg, bf16x8& pa0, bf16x8& pa1, bf16x8& pa2, bf16x8& pa3) {
#pragma unroll
  for (int r = 0; r < 16; ++r) p1[r] = __builtin_amdgcn_exp2f(p1[r]);
  float ps = 0;
#pragma unroll
  for (int r = 0; r < 16; ++r) ps += p0[r];
#pragma unroll
  for (int r = 0; r < 16; ++r) ps += p1[r];
  { auto rr = __builtin_amdgcn_permlane32_swap(__float_as_uint(ps), __float_as_uint(ps), false, false);
    ps = __uint_as_float(rr[0]) + __uint_as_float(rr[1]); }
  l_reg = l_reg * alpha + ps;
#define PK4(P, BASE, OUT) do { unsigned a0 = cvt_pk(P[BASE + 0], P[BASE + 1]), a1 = cvt_pk(P[BASE + 2], P[BASE + 3]);   \
    unsigned b0 = cvt_pk(P[BASE + 4], P[BASE + 5]), b1 = cvt_pk(P[BASE + 6], P[BASE + 7]);                              \
    auto r0 = __builtin_amdgcn_permlane32_swap(a0, b0, false, false); auto r1 = __builtin_amdgcn_permlane32_swap(a1, b1, false, false); \
    u32x4 w = {r0[0], r1[0], r0[1], r1[1]}; OUT = *reinterpret_cast<bf16x8*>(&w); } while (0)
  PK4(p0, 0, pa0); PK4(p0, 8, pa1); PK4(p1, 0, pa2); PK4(p1, 8, pa3);
#undef PK4
}
__device__ __forceinline__ void qkt(f32x16& p0, f32x16& p1, const char* Ks, const bf16x8* qr, const f32x16& negm, int r32, int hi) {
#pragma unroll
  for (int d0 = 0; d0 < 6; ++d0) { int cb = (d0 * 16 + hi * 8) * 2;
    bf16x8 b0 = *reinterpret_cast<const bf16x8*>(Ks + KSWZ(r32, cb));
    bf16x8 b1 = *reinterpret_cast<const bf16x8*>(Ks + KSWZ(32 + r32, cb));
    p0 = __builtin_amdgcn_mfma_f32_32x32x16_bf16(b0, qr[d0], d0 == 0 ? negm : p0, 0, 0, 0);
    p1 = __builtin_amdgcn_mfma_f32_32x32x16_bf16(b1, qr[d0], d0 == 0 ? negm : p1, 0, 0, 0); }
}
__device__ __forceinline__ int v_st(int k, int c) { const int kk = (k & ~0xC) | ((k & 4) << 1) | ((k & 8) >> 1); return ((kk >> 3) * 4 + (c >> 5)) * 512 + ((kk & 7) * 32 + (c & 31)) * 2; }
__device__ __forceinline__ int v_rd_base(int lane) { return ((lane & 3) << 3) | (((lane >> 2) & 3) << 6) | (((lane >> 4) & 1) << 5) | (((lane >> 5) & 1) << 8); }
constexpr int v_rd_off(int d0, int ks, int half) { return d0 * 512 + ks * 4096 + half * 2048; }
template <int OFF> __device__ __forceinline__ s16x4 tr_read(int vb) {
  s16x4 r; asm volatile("ds_read_b64_tr_b16 %0, %1 offset:%2" : "=&v"(r) : "v"(vb), "i"(OFF) : "memory"); return r;
}
template <int D0> __device__ __forceinline__ void pv_one(f32x16& od, int vb, bf16x8 pa0, bf16x8 pa1, bf16x8 pa2, bf16x8 pa3) {
  const s16x4 l0 = tr_read<v_rd_off(D0, 0, 0)>(vb), h0 = tr_read<v_rd_off(D0, 0, 1)>(vb), l1 = tr_read<v_rd_off(D0, 1, 0)>(vb), h1 = tr_read<v_rd_off(D0, 1, 1)>(vb);
  const s16x4 l2 = tr_read<v_rd_off(D0, 2, 0)>(vb), h2 = tr_read<v_rd_off(D0, 2, 1)>(vb), l3 = tr_read<v_rd_off(D0, 3, 0)>(vb), h3 = tr_read<v_rd_off(D0, 3, 1)>(vb);
  asm volatile("s_waitcnt lgkmcnt(0)" ::: "memory"); SBAR();
#define PK(L, H) (bf16x8){L[0], L[1], L[2], L[3], H[0], H[1], H[2], H[3]}
  od = __builtin_amdgcn_mfma_f32_32x32x16_bf16(pa0, PK(l0, h0), od, 0, 0, 0);
  od = __builtin_amdgcn_mfma_f32_32x32x16_bf16(pa1, PK(l1, h1), od, 0, 0, 0);
  od = __builtin_amdgcn_mfma_f32_32x32x16_bf16(pa2, PK(l2, h2), od, 0, 0, 0);
  od = __builtin_amdgcn_mfma_f32_32x32x16_bf16(pa3, PK(l3, h3), od, 0, 0, 0);
#undef PK
}
__device__ __forceinline__ void pv_d0(f32x16* o, int vb, bf16x8 pa0, bf16x8 pa1, bf16x8 pa2, bf16x8 pa3) {
  pv_one<0>(o[0], vb, pa0, pa1, pa2, pa3); pv_one<1>(o[1], vb, pa0, pa1, pa2, pa3);
}
__device__ __forceinline__ void glds16(const void* gsrc, unsigned lds_dst) { unsigned keep;
  asm volatile("s_mov_b32 %0, m0\n\ts_mov_b32 m0, %2\n\ts_nop 0\n\tglobal_load_lds_dwordx4 %1, off\n\ts_mov_b32 m0, %0" : "=&s"(keep) : "v"(gsrc), "s"(lds_dst) : "memory"); }
#define WAIT_BAR(N) asm volatile("s_waitcnt vmcnt(" #N ") lgkmcnt(0)\n\ts_barrier" ::: "memory")
constexpr int KSLOT = 16384, VSLOT = 8192, LDS_KR = 0, LDS_VR = 4 * KSLOT, LDS_WSF = LDS_VR + 4 * VSLOT;
constexpr int v_rd_off2(int d0, int ks, int half) { return d0 * 512 + ks * 2048 + half * 1024; }
__device__ __forceinline__ void pv2(f32x16* o, int vb, bf16x8 pa0, bf16x8 pa1, bf16x8 pa2, bf16x8 pa3) {
  const s16x4 a0 = tr_read<v_rd_off2(0, 0, 0)>(vb), b0 = tr_read<v_rd_off2(0, 0, 1)>(vb), c0 = tr_read<v_rd_off2(1, 0, 0)>(vb), d0 = tr_read<v_rd_off2(1, 0, 1)>(vb);
  const s16x4 a1 = tr_read<v_rd_off2(0, 1, 0)>(vb), b1 = tr_read<v_rd_off2(0, 1, 1)>(vb), c1 = tr_read<v_rd_off2(1, 1, 0)>(vb), d1 = tr_read<v_rd_off2(1, 1, 1)>(vb);
  const s16x4 a2 = tr_read<v_rd_off2(0, 2, 0)>(vb), b2 = tr_read<v_rd_off2(0, 2, 1)>(vb), c2 = tr_read<v_rd_off2(1, 2, 0)>(vb), d2 = tr_read<v_rd_off2(1, 2, 1)>(vb);
  const s16x4 a3 = tr_read<v_rd_off2(0, 3, 0)>(vb), b3 = tr_read<v_rd_off2(0, 3, 1)>(vb), c3 = tr_read<v_rd_off2(1, 3, 0)>(vb), d3 = tr_read<v_rd_off2(1, 3, 1)>(vb);
  asm volatile("s_waitcnt lgkmcnt(0)" ::: "memory"); SBAR();
#define PK(L, H) (bf16x8){L[0], L[1], L[2], L[3], H[0], H[1], H[2], H[3]}
  o[0] = __builtin_amdgcn_mfma_f32_32x32x16_bf16(pa0, PK(a0, b0), o[0], 0, 0, 0);
  o[1] = __builtin_amdgcn_mfma_f32_32x32x16_bf16(pa0, PK(c0, d0), o[1], 0, 0, 0);
  o[0] = __builtin_amdgcn_mfma_f32_32x32x16_bf16(pa1, PK(a1, b1), o[0], 0, 0, 0);
  o[1] = __builtin_amdgcn_mfma_f32_32x32x16_bf16(pa1, PK(c1, d1), o[1], 0, 0, 0);
  o[0] = __builtin_amdgcn_mfma_f32_32x32x16_bf16(pa2, PK(a2, b2), o[0], 0, 0, 0);
  o[1] = __builtin_amdgcn_mfma_f32_32x32x16_bf16(pa2, PK(c2, d2), o[1], 0, 0, 0);
  o[0] = __builtin_amdgcn_mfma_f32_32x32x16_bf16(pa3, PK(a3, b3), o[0], 0, 0, 0);
  o[1] = __builtin_amdgcn_mfma_f32_32x32x16_bf16(pa3, PK(c3, d3), o[1], 0, 0, 0);
#undef PK
}
__device__ __forceinline__ void attn_unit(const bf16_t* __restrict__ Qb, const bf16_t* __restrict__ Kh, const bf16_t* __restrict__ Vh, bf16_t* __restrict__ Ob, int seq, char* lds, const int wv, const float* __restrict__ gq, const float2* __restrict__ rt, int pos0) {
  const int tid = ltid(wv), wid = wv, lane = tid & 63, r32 = lane & 31, hi = lane >> 5;
  const unsigned lds0 = (unsigned)(uintptr_t)lds;
  float* ws = (float*)(lds + LDS_WSF) + wid * 64; float* li_l = ws; float* al_l = ws + 32;
  float m_reg = 0.f, l_reg = 0; f32x16 o[2] = {}; f32x16 negm = {}; bf16x8 qr[6];
  const bf16_t* Qw = Qb + (long)(wid * QBLK + r32) * LDQ + hi * 8;
  __syncthreads();
  {
    float v[6][8]; float ss = 0.f;
#pragma unroll
    for (int d0 = 0; d0 < 6; ++d0) { const u32x4 w = *reinterpret_cast<const u32x4*>(Qw + d0 * 16);
      v[d0][0] = bf_lo(w.x); v[d0][1] = bf_hi(w.x); v[d0][2] = bf_lo(w.y); v[d0][3] = bf_hi(w.y); v[d0][4] = bf_lo(w.z); v[d0][5] = bf_hi(w.z); v[d0][6] = bf_lo(w.w); v[d0][7] = bf_hi(w.w);
#pragma unroll
      for (int j = 0; j < 8; ++j) ss += v[d0][j] * v[d0][j]; }
    ss += __shfl_xor(ss, 32);
    const float r = (1.0f / sqrtf(ss * (1.0f / 96.0f) + EPS));
#pragma unroll
    for (int d0 = 0; d0 < 6; ++d0)
#pragma unroll
      for (int j = 0; j < 8; ++j) v[d0][j] = v[d0][j] * r * gq[d0 * 16 + hi * 8 + j];
    const int pos = pos0 + wid * QBLK + r32;
#pragma unroll
    for (int j = 0; j < 8; ++j) { const float2 cs = rt[pos * 16 + hi * 8 + j]; const float x1 = v[4][j], x2 = v[5][j]; v[4][j] = x1 * cs.x - x2 * cs.y; v[5][j] = x2 * cs.x + x1 * cs.y; }
    constexpr float CQ = 0.14724448646421766f;
#pragma unroll
    for (int d0 = 0; d0 < 6; ++d0) { u32x4 w; w.x = cvt_pk(v[d0][0] * CQ, v[d0][1] * CQ); w.y = cvt_pk(v[d0][2] * CQ, v[d0][3] * CQ); w.z = cvt_pk(v[d0][4] * CQ, v[d0][5] * CQ); w.w = cvt_pk(v[d0][6] * CQ, v[d0][7] * CQ);
      qr[d0] = __builtin_bit_cast(bf16x8, w); }
  }
  const int kq = lane >> 4, kc0 = (lane & 15) ^ kq, kc1 = (lane & 15) ^ (4 + kq);
  const char* ksrc0 = (const char*)Kh + (size_t)(8 * wid + kq) * (LDK * 2) + (kc0 > 11 ? 11 : kc0) * 16;
  const char* ksrc1 = (const char*)Kh + (size_t)(8 * wid + 4 + kq) * (LDK * 2) + (kc1 > 11 ? 11 : kc1) * 16;
  const int vkk = 8 * wid + ((lane & 31) >> 2), vk = (vkk & ~0xC) | ((vkk & 4) << 1) | ((vkk & 8) >> 1);
  const char* vsrc = (const char*)Vh + (size_t)vk * (LDV * 2) + (32 * (lane >> 5) + 8 * (lane & 3)) * 2;
  const unsigned kdst = lds0 + LDS_KR + wid * 2048, vdst = lds0 + LDS_VR + wid * 1024;
#define DMA_K(t, slot) do { const size_t o_ = (size_t)(t) * (KVBLK * LDK * 2); const unsigned d_ = (unsigned)__builtin_amdgcn_readfirstlane(kdst + (slot) * KSLOT); glds16(ksrc0 + o_, d_); glds16(ksrc1 + o_, d_ + 1024u); } while (0)
#define DMA_V(t, slot) glds16(vsrc + (size_t)(t) * (KVBLK * LDV * 2), (unsigned)__builtin_amdgcn_readfirstlane(vdst + (slot) * VSLOT))
#define RESC(a) do { if (__any((a) < 1.f)) { if (hi == 0) al_l[r32] = (a); asm volatile("s_waitcnt lgkmcnt(0)" ::: "memory"); \
    _Pragma("unroll") for (int d = 0; d < 2; ++d) _Pragma("unroll") for (int r = 0; r < 16; ++r) o[d][r] *= al_l[crow(r, hi)]; } } while (0)
  const int vb0 = (int)lds0 + LDS_VR + v_rd_base(lane);
  f32x16 pA0, pA1, pB0, pB1; float alA, alB; bf16x8 pa0, pa1, pa2, pa3; const int NT = seq / KVBLK;
  DMA_K(0, 0); DMA_K(1, 1); DMA_V(0, 0);
  WAIT_BAR(0);
#define STEP(C0, C1, alC, P0, P1, alP, t) do { \
    SBAR(); qkt(C0, C1, lds + LDS_KR + ((t) & 3) * KSLOT, qr, negm, r32, hi); \
    finishSM(P0, P1, alP, l_reg, pa0, pa1, pa2, pa3); SBAR(); \
    pv2(o, vb0 + (((t) - 1) & 3) * VSLOT, pa0, pa1, pa2, pa3); partialSM<false>(C0, C1, m_reg, negm, alC); \
    RESC(alC); } while (0)
  DMA_K(2, 2); DMA_K(3, 3); DMA_V(1, 1); DMA_V(2, 2);
  qkt(pA0, pA1, lds + LDS_KR, qr, negm, r32, hi); partialSM<true>(pA0, pA1, m_reg, negm, alA);
  STEP(pB0, pB1, alB, pA0, pA1, alA, 1);
  WAIT_BAR(0);
  for (int t = 2; t < NT; t += 2) {
    if (t + 2 < NT) { DMA_K(t + 2, (t + 2) & 3); DMA_K(t + 3, (t + 3) & 3); }
    if (t + 1 < NT) DMA_V(t + 1, (t + 1) & 3); if (t + 2 < NT) DMA_V(t + 2, (t + 2) & 3);
    STEP(pA0, pA1, alA, pB0, pB1, alB, t);
    STEP(pB0, pB1, alB, pA0, pA1, alA, t + 1);
    WAIT_BAR(0);
  }
  finishSM(pB0, pB1, alB, l_reg, pa0, pa1, pa2, pa3); SBAR();
  pv2(o, vb0 + ((NT - 1) & 3) * VSLOT, pa0, pa1, pa2, pa3);
  if (hi == 0) li_l[r32] = l_reg; asm volatile("s_waitcnt lgkmcnt(0)" ::: "memory");
  float rli[16];
#pragma unroll
  for (int r = 0; r < 16; ++r) rli[r] = __builtin_amdgcn_rcpf(li_l[crow(r, hi)]);
  bf16_t* Ow = Ob + (long)(wid * QBLK) * LDO;
#pragma unroll
  for (int r = 0; r < 16; ++r) { const int orow = crow(r, hi);
#pragma unroll
    for (int d0 = 0; d0 < 2; ++d0) Ow[(long)orow * LDO + d0 * 32 + r32] = (bf16_t)(cvt_pk(o[d0][r] * rli[r], 0.f) & 0xffffu); }
  asm volatile("s_waitcnt lgkmcnt(0)\n\ts_barrier" ::: "memory");
#undef DMA_K
#undef DMA_V
#undef RESC
#undef STEP
}
#undef SBAR
}

__device__ __forceinline__ void attention_phase(const Args& a, unsigned char* lds, const int wv, int l) {
    unsigned char* ws = a.ws; const float* gq = a.in[8] + l * DQK; const float2* rt = (const float2*)(ws + WS_ROPE);
    const bf16_t* Qb = (const bf16_t*)(ws + WS_QB); const bf16_t* Kb = (const bf16_t*)(ws + WS_KB); const bf16_t* KV = (const bf16_t*)(ws + WS_KVRAW); bf16_t* FA = (bf16_t*)(ws + WS_FA);
    const int G = lgdim();
    for (int u = lbid(); u < 512; u += G) { const int h = u & 7, qb = u >> 3; const size_t t0 = TP;
        att::attn_unit(Qb + (t0 + (size_t)qb * 256) * 768 + h * 96, Kb + t0 * 768 + h * 96, KV + t0 * 1024 + h * 128 + 64, FA + (t0 + (size_t)qb * 256) * 1024 + 512 + h * 64, 16384, (char*)lds, wv, gq, rt, qb * 256); }
    for (int u = lbid() * 8; u < 2048; u += G * 8)
        for (int qb = 0; qb < 8; ++qb) { const int bh = u >> 3, b = bh >> 3, h = bh & 7; const size_t t0 = (size_t)b * 2048;
            att::attn_unit(Qb + (t0 + (size_t)qb * 256) * 768 + h * 96, Kb + t0 * 768 + h * 96, KV + t0 * 1024 + h * 128 + 64, FA + (t0 + (size_t)qb * 256) * 1024 + 512 + h * 64, 2048, (char*)lds, wv, gq, rt, qb * 256); }
    __syncthreads();
}


typedef const __attribute__((address_space(4))) Args* KArgs;
extern __shared__ __attribute__((aligned(16))) unsigned char lds_dyn[];

__device__ __forceinline__ void grid_barrier(unsigned* ctr, unsigned target, const int wv) {
    asm volatile("s_waitcnt vmcnt(0)" ::: "memory");
    __syncthreads();
    if (ltid(wv) == 0) {
        __builtin_amdgcn_fence(__ATOMIC_RELEASE, "agent");
        asm volatile("s_waitcnt vmcnt(0)" ::: "memory");
        __hip_atomic_fetch_add(ctr, 1u, __ATOMIC_RELAXED, __HIP_MEMORY_SCOPE_AGENT);
        unsigned spins = 0;
        while (__hip_atomic_load(ctr, __ATOMIC_RELAXED, __HIP_MEMORY_SCOPE_AGENT) < target) { __builtin_amdgcn_s_sleep(2); if (++spins > (1u << 24)) break; }
        __builtin_amdgcn_fence(__ATOMIC_ACQUIRE, "agent");
        asm volatile("s_waitcnt vmcnt(0)" ::: "memory");
    }
    __syncthreads();
}

constexpr int LDS_BYTES = 131072;
constexpr int N_PHASES = 17;
#ifndef PH_MASK
#define PH_MASK 0xfff
#endif
#define EN(k) (((PH_MASK) >> (k)) & 1)
#ifndef PROBE_PH
#define PROBE_PH -1
#endif
#ifndef PROBE_OFF0
#define PROBE_OFF0 230
#endif
#ifndef PROBE_OFF1
#define PROBE_OFF1 -1
#endif
#ifndef PROBE_N1
#define PROBE_N1 0
#endif
#ifndef MK_PER_PHASE
#define MK_PER_PHASE 0
#endif
template <class Epi> __device__ __forceinline__ void run_gemm(unsigned char* lds, const bf16_t* A, int lda, const bf16_t* Bt, int ldb, int N, int K, const Epi& E, const int wv) {
    asm volatile("" : "+s"(K));
    pg8::Gemm g{A, Bt, T, N, K, lda, ldb}; pg8::StaticOrder S; S.init(T, N, lgdim(), lbid());
    pg8::gemm_phase<Epi, pg8::StaticOrder, true, true>((LAS unsigned char*)lds, g, S, E, wv);
}
__device__ __forceinline__ void do_phase(const Args& a_, const int ph, unsigned char* lds, const int wv) {
#if defined(__HIP_DEVICE_COMPILE__)
        const __attribute__((address_space(4))) Args* ap = (const __attribute__((address_space(4))) Args*)__builtin_amdgcn_kernarg_segment_ptr(); asm volatile("" : "+s"(ap));
        const Args a = *ap;
#else
        const Args a = a_;
#endif
        unsigned char* ws = a.ws;
        u64* ssq_all = (u64*)(ws + WS_SSQ);
        bf16_t* AB = (bf16_t*)(ws + WS_AB);
#if PROBE_PH >= 0
        if (ph == 100) {
            const bf16_t* b0 = (const bf16_t*)(ws + PROBE_OFF0 * MiB); const bf16_t* b1 = (const bf16_t*)(ws + PROBE_OFF1 * MiB);
            for (size_t i = (size_t)lbid() * 512 + ltid(wv); i < (size_t)T * DM; i += (size_t)lgdim() * 512) {
                float v = __uint_as_float((unsigned)b0[i] << 16); if (PROBE_OFF1 >= 0 && i < (size_t)PROBE_N1) v += __uint_as_float((unsigned)b1[i] << 16);
                a.out[i] = v; }
        } else
#endif
        if (ph == 0) { if (EN(9)) p0_prologue(a, lds, wv); }
        else {
            const int l = (ph - 1) / 8, j0 = (ph - 1) % 8, j = j0 < 4 ? j0 : j0 + 1;
            unsigned char* wl = ws + WS_W + (size_t)l * W_LAYER;
            u64* ssq_x = ssq_all + (size_t)(l * 4 + 0) * T; u64* ssq_q = ssq_all + (size_t)(l * 4 + 1) * T; u64* ssq_kv = ssq_all + (size_t)(l * 4 + 2) * T; u64* ssq_h = ssq_all + (size_t)(l * 4 + 3) * T;
            if (j == 0 && EN(0)) {
                EpiIn E{(bf16_t*)(ws + WS_VC), (bf16_t*)(ws + WS_CQ), (bf16_t*)(ws + WS_CKV), ssq_x, ssq_q, ssq_kv, (bf16_t*)a.out};
                run_gemm(lds, AB, 1024, (const bf16_t*)(wl + WO_IN1), 1024, 3584, 1024, E, wv);
            } else if (j == 1 && EN(1)) {
                { EpiRowScale<0> E{(bf16_t*)(ws + WS_QB), 768, ssq_q, 1.0f / 256.0f}; run_gemm(lds, (const bf16_t*)(ws + WS_CQ), 256, (const bf16_t*)(wl + WO_UQ), 256, 768, 256, E, wv); }
                { EpiRowScale<3> E{(bf16_t*)(ws + WS_KVRAW), 1024, ssq_kv, 1.0f / 128.0f}; run_gemm(lds, (const bf16_t*)(ws + WS_CKV), 256, (const bf16_t*)(wl + WO_UKV), 128, 1024, 128, E, wv); }
            } else if (j == 2) {
                if (EN(2)) finalize_qk(a, l, wv); if (EN(10)) fourier_stage1(a, lds, wv);
            } else if (j == 3) {
                if (EN(3)) attention_phase(a, lds, wv, l); if (EN(11)) fourier_stage2(a, lds, wv);
            } else if (j == 4 && EN(4)) {
                EpiRowScale<1> E{(bf16_t*)(ws + WS_GG), 2048, ssq_x, 1.0f / 1024.0f};
                run_gemm(lds, AB, 1024, (const bf16_t*)(wl + WO_G), 1024, 2048, 1024, E, wv);
            } else if (j == 5 && EN(5)) {
                { EpiMixK E{(bf16_t*)(ws + WS_MB), (const bf16_t*)a.out}; run_gemm(lds, (const bf16_t*)(ws + WS_FA), 1024, (const bf16_t*)(wl + WO_OF), 1024, 1024, 1024, E, wv); }
            } else if (j == 6 && EN(6)) {
                if (l == 0) { EpiResid<false, true, false> E{a.in[0], a.in[1], nullptr, AB, ssq_h}; run_gemm(lds, (const bf16_t*)(ws + WS_MB), 1024, (const bf16_t*)(wl + WO_OUT), 1024, 1024, 1024, E, wv); }
                else { EpiResid<true, true, false> E{nullptr, nullptr, nullptr, AB, ssq_h}; run_gemm(lds, (const bf16_t*)(ws + WS_MB), 1024, (const bf16_t*)(wl + WO_OUT), 1024, 1024, 1024, E, wv); }
            } else if (j == 7 && EN(7)) {
                EpiRowScale<2> E{(bf16_t*)(ws + WS_UB), 4096, ssq_h, 1.0f / 1024.0f};
                run_gemm(lds, AB, 1024, (const bf16_t*)(wl + WO_UP), 1024, 4096, 1024, E, wv);
            } else if (j == 8 && EN(8)) {
                if (l == 0) { EpiResid<true, true, false> E{nullptr, nullptr, nullptr, AB, ssq_all + (size_t)4 * T}; run_gemm(lds, (const bf16_t*)(ws + WS_UB), 4096, (const bf16_t*)(wl + WO_DN), 4096, 1024, 4096, E, wv); }
                else { EpiResid<true, false, true> E{nullptr, nullptr, a.out, AB, nullptr}; run_gemm(lds, (const bf16_t*)(ws + WS_UB), 4096, (const bf16_t*)(wl + WO_DN), 4096, 1024, 4096, E, wv); }
            }
        }
}
__global__ void __launch_bounds__(512, 2) mega_fwd(Args a_) {
    unsigned char* lds = lds_dyn;
    cg::grid_group grid = cg::this_grid();
    const int ph_lo = a_.ph_lo, ph_hi = a_.ph_hi;
    const int wv = __builtin_amdgcn_readfirstlane((int)threadIdx.x >> 6);
    unsigned* bar = (unsigned*)(a_.ws + WS_BAR);
#define STEP(k) if (ph_lo <= (k) && (k) < ph_hi) { do_phase(a_, (k), lds, wv); if ((k) + 1 < ph_hi) { if ((k) == ph_lo) grid.sync(); else grid_barrier(bar, (unsigned)((k) - ph_lo) * (unsigned)lgdim(), wv); } }
    STEP(0) STEP(1) STEP(2) STEP(3) STEP(4) STEP(5) STEP(6) STEP(7) STEP(8) STEP(9) STEP(10) STEP(11) STEP(12) STEP(13) STEP(14) STEP(15) STEP(16)
#if PROBE_PH >= 0
    STEP(100)
#endif
#undef STEP
}

extern "C" void kernel_launch(void* const* d_in, const int* in_sizes, int n_in, void* d_out, int out_size, void* d_ws, size_t ws_size, hipStream_t stream) {
    static int grid = 0;
    if (grid == 0) {
        if (n_in != 16 || out_size != T * DM || ws_size < WS_END) { fprintf(stderr, "kernel_launch: unexpected shapes (n_in %d out %d ws %zu, need ws >= %zu)\n", n_in, out_size, ws_size, (size_t)WS_END); grid = -1; return; }
        int dev = 0, cus = 0, per_cu = 0;
        if (hipGetDevice(&dev) != hipSuccess || hipDeviceGetAttribute(&cus, hipDeviceAttributeMultiprocessorCount, dev) != hipSuccess) { fprintf(stderr, "kernel_launch: device query failed\n"); grid = -1; return; }
        if (hipFuncSetAttribute((const void*)mega_fwd, hipFuncAttributeMaxDynamicSharedMemorySize, LDS_BYTES) != hipSuccess) { fprintf(stderr, "kernel_launch: hipFuncSetAttribute failed\n"); grid = -1; return; }
        if (hipOccupancyMaxActiveBlocksPerMultiprocessor(&per_cu, (const void*)mega_fwd, 512, LDS_BYTES) != hipSuccess || per_cu < 1) { fprintf(stderr, "kernel_launch: occupancy query says %d\n", per_cu); per_cu = 1; }
        (void)hipGetLastError();
        grid = cus;
        if (grid % 8 != 0 || grid <= 0) { fprintf(stderr, "kernel_launch: unexpected CU count %d\n", cus); grid = -1; return; }
    }
    if (grid < 0) return;
    if (hipMemsetAsync((char*)d_ws + WS_BAR, 0, 4096, stream) != hipSuccess) { fprintf(stderr, "kernel_launch: memset failed\n"); return; }
    Args a{};
    for (int i = 0; i < 16; ++i) a.in[i] = (const float*)d_in[i];
    a.out = (float*)d_out; a.ws = (unsigned char*)d_ws;
#if MK_PER_PHASE
    for (int ph = 0; ph < N_PHASES; ++ph) { if (PROBE_PH >= 0 && ph > PROBE_PH) break; a.ph_lo = ph; a.ph_hi = ph + 1; hipLaunchKernelGGL(mega_fwd, dim3(grid), dim3(512), LDS_BYTES, stream, a); }
    if (PROBE_PH >= 0) { a.ph_lo = 100; a.ph_hi = 101; hipLaunchKernelGGL(mega_fwd, dim3(grid), dim3(512), LDS_BYTES, stream, a); }
#else
    a.ph_lo = 0; a.ph_hi = N_PHASES;
    void* args[] = {&a};
    hipError_t e = hipLaunchCooperativeKernel((const void*)mega_fwd, dim3(grid), dim3(512), args, LDS_BYTES, stream);
    if (e != hipSuccess) fprintf(stderr, "cooperative launch failed: %s (grid %d)\n", hipGetErrorString(e), grid);
#endif
}
```

```cpp
#include <hip/hip_runtime.h>
#include <hip/hip_cooperative_groups.h>
#include <cstdio>
#include <cstdint>
namespace cg = cooperative_groups;
__device__ __forceinline__ int lbid() { int b = blockIdx.x; asm volatile("" : "+s"(b)); return b; }
__device__ __forceinline__ int lgdim() { int g = gridDim.x; asm volatile("" : "+s"(g)); return g; }
__device__ __forceinline__ int ltid(int wv) { int t = (wv << 6) | (int)__builtin_amdgcn_mbcnt_hi(~0u, __builtin_amdgcn_mbcnt_lo(~0u, 0u)); asm volatile("" : "+v"(t)); return t; }
namespace pg8 {
#define PG8_LAS __attribute__((address_space(3)))
typedef unsigned short bf16_t;
typedef short bf16x8 __attribute__((ext_vector_type(8)));
typedef float f32x4 __attribute__((ext_vector_type(4)));
typedef unsigned u32x4 __attribute__((ext_vector_type(4)));
constexpr int BM = 256, BK = 64, HALF = 128, HTB = HALF * BK * 2  , STAGE_BYTES = 8 * HTB, NXCD = 8, WGM = 8;

__host__ __device__ __forceinline__ int lds_byte(int r, int c) { const int st = (r >> 4) * 2 + (c >> 5), rr = r & 15, cc = c & 31, ob = rr * 64 + cc * 2; return st * 1024 + (ob ^ (((ob >> 9) & 1) << 5)); }
__host__ __device__ __forceinline__ void stage_rc(int b, int& R, int& C) { const int st = b / 1024, sb = b % 1024, swz = sb ^ (((sb >> 9) & 1) << 5); R = (st >> 1) * 16 + swz / 64; C = (st & 1) * 32 + (swz % 64) / 2; }
__host__ __device__ __forceinline__ int perm32(int rho) { const int n = rho >> 4, i = rho & 15; return 8 * (i >> 2) + 4 * n + (i & 3); }

struct Unit { int pm, pn; };
struct Gemm { const bf16_t* A; const bf16_t* Bt; int M, N, K, lda, ldb; };

struct StaticOrder {
    int nM, nN, nwg, G, c;
    __host__ __device__ void init(int M, int N, int G_, int c_) { nM = M / BM; nN = N / BM; nwg = nM * nN; G = G_; c = c_; }
    __host__ __device__ bool next(int i, Unit& u) const {
        const long L = (long)i * G + c; if (L >= nwg) return false;
        int wgid = (int)L; { const int q = nwg / NXCD, r = nwg % NXCD, xcd = wgid % NXCD, off = wgid / NXCD; wgid = (xcd < r ? xcd * (q + 1) : r * (q + 1) + (xcd - r) * q) + off; }
        const int nig = WGM * nN, gid = wgid / nig, fm = gid * WGM, gsz = (nM - fm) < WGM ? (nM - fm) : WGM;
        u.pm = fm + ((wgid % nig) % gsz); u.pn = (wgid % nig) / gsz; return true;
    }
    __device__ __forceinline__ void a_ready(const Unit&) const {}
    __device__ __forceinline__ void done(const Unit&) const {}
};


template <class Epi, class Sched, bool ALIGN_EPI = false, bool SP2 = false>
__device__ __forceinline__ void gemm_phase(PG8_LAS unsigned char* lds, const Gemm g, const Sched& S, const Epi& E, const int wv) {
    const int tid = ltid(wv), wid = __builtin_amdgcn_readfirstlane(tid >> 6), lane = tid & 63, wr = wid >> 2, wc = wid & 3, fr = lane & 15, fq = lane >> 4;
    const int K = g.K, nt = K / BK;
    unsigned voffA[2], voffB[2];
#pragma unroll
    for (int i = 0; i < 2; ++i) { int R, C; stage_rc(tid * 16 + i * 8192, R, C); const int Rb = Epi::PERM ? ((R & ~31) + perm32(R & 31)) : R;
        voffA[i] = (unsigned)(R * g.lda + C) * 2u; voffB[i] = (unsigned)(Rb * g.ldb + C) * 2u; }
    const size_t kstep = (size_t)(BK * 2);
    const size_t hstepA = (size_t)HALF * g.lda * 2, hstepB = (size_t)HALF * g.ldb * 2;
    const size_t tstepA = 2 * hstepA, tstepB = 2 * hstepB;
    const unsigned ldsw = (unsigned)wid * 1024u;
    const int aoff = lds_byte(wr * 64 + fr, fq * 8), boff = lds_byte(wc * 32 + fr, fq * 8);
#define PG8_SA(b, h) (((b) * 2 + (h)) * HTB)
#define PG8_SB(b, h) ((4 + (b) * 2 + (h)) * HTB)
#define PG8_STAGE(bufoff, gbase, voff) do { _Pragma("unroll") for (int _i = 0; _i < 2; ++_i) \
        __builtin_amdgcn_global_load_lds((const unsigned*)((const char*)(gbase) + (voff)[_i]), (PG8_LAS unsigned*)(lds + (bufoff) + ldsw + _i * 8192), 16, 0, 0); } while (0)
#define PG8_LDA(dst, b, h) do { _Pragma("unroll") for (int m = 0; m < 4; ++m) _Pragma("unroll") for (int k = 0; k < 2; ++k) dst[m][k] = *(const PG8_LAS bf16x8*)(lds + PG8_SA(b, h) + aoff + m * 2048 + k * 1024); } while (0)
#define PG8_LDB(dst, b, h) do { _Pragma("unroll") for (int n = 0; n < 2; ++n) _Pragma("unroll") for (int k = 0; k < 2; ++k) dst[n][k] = *(const PG8_LAS bf16x8*)(lds + PG8_SB(b, h) + boff + n * 2048 + k * 1024); } while (0)
#define PG8_MMA(ai, bj, At, Bt) do { __builtin_amdgcn_s_setprio(1); _Pragma("unroll") for (int m = 0; m < 4; ++m) _Pragma("unroll") for (int n = 0; n < 2; ++n) _Pragma("unroll") for (int k = 0; k < 2; ++k) \
        acc[ai][bj][m][n] = __builtin_amdgcn_mfma_f32_16x16x32_bf16(Bt[n][k], At[m][k], acc[ai][bj][m][n], 0, 0, 0); __builtin_amdgcn_s_setprio(0); } while (0)
#define PG8_WAIT_V(n) asm volatile("s_waitcnt vmcnt(" #n ")" ::: "memory")
#define PG8_WAIT_L(n) asm volatile("s_waitcnt lgkmcnt(" #n ")" ::: "memory")
#define PG8_BAR __builtin_amdgcn_s_barrier()
#define PG8_SCHED __builtin_amdgcn_sched_barrier(0)
    Unit cur, nxt; int ui = 0;
    if (!S.next(0, cur)) return;
    f32x4 acc[2][2][4][2];
#pragma unroll
    for (int a = 0; a < 2; ++a)
#pragma unroll
        for (int b = 0; b < 2; ++b)
#pragma unroll
            for (int m = 0; m < 4; ++m)
#pragma unroll
                for (int n = 0; n < 2; ++n) acc[a][b][m][n] = (f32x4){0.f, 0.f, 0.f, 0.f};
    bf16x8 At[4][2], B0[2][2], B1[2][2];
    const char* cA = (const char*)g.A + (size_t)cur.pm * tstepA; const char* cB = (const char*)g.Bt + (size_t)cur.pn * tstepB;
    S.a_ready(cur);
    if constexpr (SP2) {
        PG8_STAGE(PG8_SB(0, 0), cB, voffB); PG8_STAGE(PG8_SB(0, 1), cB + hstepB, voffB); PG8_STAGE(PG8_SA(0, 0), cA, voffA); PG8_STAGE(PG8_SA(0, 1), cA + hstepA, voffA);
        if (wr == 1) PG8_BAR;
        PG8_WAIT_V(2); PG8_BAR;
        PG8_STAGE(PG8_SB(1, 0), cB + kstep, voffB); PG8_STAGE(PG8_SA(1, 0), cA + kstep, voffA); PG8_STAGE(PG8_SB(1, 1), cB + hstepB + kstep, voffB);
        PG8_WAIT_V(6); PG8_BAR;
    } else {
        PG8_STAGE(PG8_SB(0, 0), cB, voffB); PG8_STAGE(PG8_SA(0, 0), cA, voffA); PG8_STAGE(PG8_SB(0, 1), cB + hstepB, voffB); PG8_STAGE(PG8_SA(0, 1), cA + hstepA, voffA);
        if (wr == 1) PG8_BAR;
        PG8_WAIT_V(4); PG8_BAR;
        PG8_STAGE(PG8_SB(1, 0), cB + kstep, voffB); PG8_STAGE(PG8_SA(1, 0), cA + kstep, voffA); PG8_STAGE(PG8_SB(1, 1), cB + hstepB + kstep, voffB);
        PG8_WAIT_V(6); PG8_BAR;
    }
    for (;;) {
        const bool has_next = S.next(ui + 1, nxt);
        const char* nA = has_next ? (const char*)g.A + (size_t)nxt.pm * tstepA : cA; const char* nB = has_next ? (const char*)g.Bt + (size_t)nxt.pn * tstepB : cB;
        for (int t = 0; t < nt; t += 2) {
            const bool last = (t == nt - 2);
            const char* a1 = cA + (size_t)(t + 1) * kstep;
            const char* a2 = last ? nA : cA + (size_t)(t + 2) * kstep; const char* b2 = last ? nB : cB + (size_t)(t + 2) * kstep;
            const char* a3 = a2 + kstep; const char* b3 = b2 + kstep;
            if (last && has_next) S.a_ready(nxt);
            if constexpr (SP2) {
            PG8_LDB(B0, 0, 0); PG8_LDB(B1, 0, 1); PG8_SCHED; PG8_LDA(At, 0, 0); PG8_STAGE(PG8_SA(1, 1), a1 + hstepA, voffA);
            PG8_WAIT_V(8); PG8_WAIT_L(0); PG8_BAR; PG8_MMA(0, 0, At, B0); PG8_MMA(0, 1, At, B1); PG8_BAR; PG8_SCHED;
            PG8_LDA(At, 0, 1); PG8_STAGE(PG8_SB(0, 0), b2, voffB); PG8_STAGE(PG8_SB(0, 1), b2 + hstepB, voffB); PG8_STAGE(PG8_SA(0, 0), a2, voffA);
            PG8_WAIT_V(8); PG8_WAIT_L(0); PG8_BAR; PG8_MMA(1, 0, At, B0); PG8_MMA(1, 1, At, B1); PG8_BAR; PG8_SCHED;
            PG8_LDB(B0, 1, 0); PG8_LDB(B1, 1, 1); PG8_SCHED; PG8_LDA(At, 1, 0); PG8_STAGE(PG8_SA(0, 1), a2 + hstepA, voffA);
            PG8_WAIT_V(8); PG8_WAIT_L(0); PG8_BAR; PG8_MMA(0, 0, At, B0); PG8_MMA(0, 1, At, B1); PG8_BAR; PG8_SCHED;
            PG8_LDA(At, 1, 1); PG8_STAGE(PG8_SB(1, 0), b3, voffB); PG8_STAGE(PG8_SB(1, 1), b3 + hstepB, voffB); PG8_STAGE(PG8_SA(1, 0), a3, voffA);
            PG8_WAIT_V(8); PG8_WAIT_L(0); PG8_BAR; PG8_MMA(1, 0, At, B0); PG8_MMA(1, 1, At, B1); PG8_BAR; PG8_SCHED;
            } else {
            PG8_LDB(B0, 0, 0); PG8_SCHED; PG8_LDA(At, 0, 0); PG8_STAGE(PG8_SA(1, 1), a1 + hstepA, voffA);
            PG8_WAIT_L(8); PG8_BAR; PG8_WAIT_L(0); PG8_MMA(0, 0, At, B0); PG8_BAR; PG8_SCHED;
            PG8_LDB(B1, 0, 1); PG8_STAGE(PG8_SB(0, 0), b2, voffB);
            PG8_BAR; PG8_WAIT_L(0); PG8_MMA(0, 1, At, B1); PG8_BAR;
            PG8_LDA(At, 0, 1); PG8_STAGE(PG8_SA(0, 0), a2, voffA);
            PG8_BAR; PG8_WAIT_L(0); PG8_MMA(1, 0, At, B0); PG8_BAR; PG8_SCHED;
            PG8_STAGE(PG8_SB(0, 1), b2 + hstepB, voffB);
            PG8_WAIT_V(6); PG8_BAR; PG8_MMA(1, 1, At, B1); PG8_BAR;
            PG8_LDB(B0, 1, 0); PG8_SCHED; PG8_LDA(At, 1, 0); PG8_STAGE(PG8_SA(0, 1), a2 + hstepA, voffA);
            PG8_WAIT_L(8); PG8_BAR; PG8_WAIT_L(0); PG8_MMA(0, 0, At, B0); PG8_BAR; PG8_SCHED;
            PG8_LDB(B1, 1, 1); PG8_STAGE(PG8_SB(1, 0), b3, voffB);
            PG8_BAR; PG8_WAIT_L(0); PG8_MMA(0, 1, At, B1); PG8_BAR;
            PG8_LDA(At, 1, 1); PG8_STAGE(PG8_SA(1, 0), a3, voffA);
            PG8_BAR; PG8_WAIT_L(0); PG8_MMA(1, 0, At, B0); PG8_BAR; PG8_SCHED;
            PG8_STAGE(PG8_SB(1, 1), b3 + hstepB, voffB);
            PG8_WAIT_V(6); PG8_BAR; PG8_MMA(1, 1, At, B1); PG8_BAR;
            }
            if constexpr (Epi::MIDK) { if (t + 2 == (nt >> 1)) E.mid(acc, cur, wr, wc, fr, fq); }
        }
        if constexpr (ALIGN_EPI) { if (wr == 0) PG8_BAR; }
        if constexpr (!Epi::AFTER_DRAIN) { E(acc, cur, wr, wc, fr, fq); S.done(cur); }
        if (!has_next) break;
#pragma unroll
        for (int a = 0; a < 2; ++a)
#pragma unroll
            for (int b = 0; b < 2; ++b)
#pragma unroll
                for (int m = 0; m < 4; ++m)
#pragma unroll
                    for (int n = 0; n < 2; ++n) acc[a][b][m][n] = (f32x4){0.f, 0.f, 0.f, 0.f};
        cur = nxt; cA = nA; cB = nB; ++ui;
        if constexpr (ALIGN_EPI) { if (wr == 1) PG8_BAR; }
    }
    PG8_WAIT_V(0);
    if constexpr (!ALIGN_EPI) { if (wr == 0) PG8_BAR; }
    PG8_BAR;
    if constexpr (Epi::AFTER_DRAIN) { E.fused(acc, cur, wr, wc, fr, fq, lds, wid, lane); S.done(cur); }
#undef PG8_SA
#undef PG8_SB
#undef PG8_STAGE
#undef PG8_LDA
#undef PG8_LDB
#undef PG8_MMA
#undef PG8_WAIT_V
#undef PG8_WAIT_L
#undef PG8_BAR
#undef PG8_SCHED
}
}


#define LAS __attribute__((address_space(3)))
using pg8::bf16_t; using pg8::bf16x8; using pg8::f32x4; using pg8::u32x4; using pg8::Unit;
typedef float f32x16 __attribute__((ext_vector_type(16)));
typedef unsigned u32x2 __attribute__((ext_vector_type(2)));
typedef short s16x4 __attribute__((ext_vector_type(4)));
constexpr int DM = 1024, TP = 65536, TS = 16384, T = TP + TS;
constexpr int NH = 8, DQK = 96, DFF = 4096, INW = 2976;
constexpr float EPS = 1e-6f;
constexpr size_t MiB = (size_t)1 << 20;
constexpr size_t WS_SSQ = 0;
constexpr size_t WS_BAR = 5 * MiB + 832 * 1024;
constexpr size_t WS_ROPE = 950 * MiB;
constexpr size_t WS_M1A = 5 * MiB, WS_M1B = 5 * MiB + 65536, WS_M2A = 5 * MiB + 262144, WS_M2B = 6 * MiB;
constexpr size_t WS_W = 14 * MiB, W_LAYER = 28 * MiB;
constexpr size_t WO_IN1 = 0, WO_G = 3 * MiB, WO_UQ = 7 * MiB, WO_UKV = 7 * MiB + 393216, WO_OF = 8 * MiB, WO_OA = 9 * MiB, WO_OUT = 10 * MiB, WO_UP = 12 * MiB, WO_DN = 20 * MiB;
constexpr size_t WS_AB = 70 * MiB;
constexpr size_t WS_BIG = 230 * MiB;
constexpr size_t WS_VC = WS_BIG, WS_KVRAW = WS_BIG + 160 * MiB, WS_QB = WS_BIG + 320 * MiB, WS_KB = WS_BIG + 440 * MiB;
constexpr size_t WS_CQ = WS_BIG + 560 * MiB, WS_CKV = WS_BIG + 600 * MiB, WS_FA = WS_BIG + 560 * MiB;
constexpr size_t WS_GG = WS_BIG, WS_MB = WS_BIG + 320 * MiB, WS_UB = WS_BIG;
constexpr size_t WS_END = 952 * MiB;

typedef float f32x2_t __attribute__((ext_vector_type(2))); typedef __bf16 bf16x2_t __attribute__((ext_vector_type(2)));
__device__ __forceinline__ unsigned cvt_pk(float lo, float hi) { f32x2_t v = {lo, hi}; bf16x2_t b = __builtin_convertvector(v, bf16x2_t); return __builtin_bit_cast(unsigned, b); }
__device__ __forceinline__ float bf_lo(unsigned w) { return __uint_as_float(w << 16); }
__device__ __forceinline__ float bf_hi(unsigned w) { return __uint_as_float(w & 0xffff0000u); }
__device__ __forceinline__ u32x4 pack8(f32x4 a, f32x4 b) { u32x4 w; w.x = cvt_pk(a[0], a[1]); w.y = cvt_pk(a[2], a[3]); w.z = cvt_pk(b[0], b[1]); w.w = cvt_pk(b[2], b[3]); return w; }
__device__ __forceinline__ float sumsq8(f32x4 a, f32x4 b) { return (a[0] * a[0] + a[1] * a[1]) + (a[2] * a[2] + a[3] * a[3]) + (b[0] * b[0] + b[1] * b[1]) + (b[2] * b[2] + b[3] * b[3]); }
__device__ __forceinline__ void unpack8(u32x4 w, f32x4& a, f32x4& b) { a[0] = bf_lo(w.x); a[1] = bf_hi(w.x); a[2] = bf_lo(w.y); a[3] = bf_hi(w.y); b[0] = bf_lo(w.z); b[1] = bf_hi(w.z); b[2] = bf_lo(w.w); b[3] = bf_hi(w.w); }
typedef unsigned long long u64;
__device__ __forceinline__ float rs_of(u64 ssq, float inv_n) { return 1.0f / sqrtf(__ull2float_rn(ssq) * 2.3283064365386963e-10f * inv_n + EPS); }
__device__ __forceinline__ void ssq_add(u64* p, float s) { atomicAdd(p, __float2ull_rn(s * 4294967296.0f)); }

struct EpiIn {
    static constexpr bool PERM = true, AFTER_DRAIN = false, MIDK = false;
    bf16_t* Vc; bf16_t* CQ; bf16_t* CKV; const u64* ssq_x; u64* ssq_q; u64* ssq_kv; bf16_t* GG;
    __device__ __forceinline__ void operator()(const f32x4 (&acc)[2][2][4][2], const Unit& u, int wr, int wc, int fr, int fq) const {
        const int row0 = u.pm * 256 + wr * 64 + fr;
        if (u.pn >= 6) {
            const int col0 = (u.pn - 6) * 256 + wc * 32 + 8 * fq;
#pragma unroll
            for (int ai = 0; ai < 2; ++ai)
#pragma unroll
                for (int m = 0; m < 4; ++m) {
                    const int row = row0 + ai * 128 + m * 16;
                    const float rs = rs_of(ssq_x[row], 1.0f / 1024.0f);
                    bf16_t* rp = GG + (size_t)row * 2048 + col0;
#pragma unroll
                    for (int bj = 0; bj < 2; ++bj) { f32x4 v0 = acc[ai][bj][m][0] * rs, v1 = acc[ai][bj][m][1] * rs;
#pragma unroll
                        for (int e = 0; e < 4; ++e) { v0[e] = __builtin_amdgcn_rcpf(1.0f + __expf(-v0[e])); v1[e] = __builtin_amdgcn_rcpf(1.0f + __expf(-v1[e])); }
                        *(u32x4*)(rp + bj * 128) = pack8(v0, v1); }
                }
            return;
        }
        bf16_t* base; int ldc, colt; u64* ssq;
        if (u.pn < 4) { base = Vc; ldc = 1024; colt = u.pn * 256; ssq = nullptr; }
        else if (u.pn == 4) { base = CQ; ldc = 256; colt = 0; ssq = ssq_q; }
        else { base = CKV; ldc = 256; colt = 0; ssq = ssq_kv; }
        const bool only0 = (u.pn == 5);
        const int col0 = colt + wc * 32 + 8 * fq;
#pragma unroll
        for (int ai = 0; ai < 2; ++ai)
#pragma unroll
            for (int m = 0; m < 4; ++m) {
                const int row = row0 + ai * 128 + m * 16;
                const float rs = rs_of(ssq_x[row], 1.0f / 1024.0f);
                const f32x4 a0 = acc[ai][0][m][0] * rs, a1 = acc[ai][0][m][1] * rs, b0 = acc[ai][1][m][0] * rs, b1 = acc[ai][1][m][1] * rs;
                bf16_t* rp = base + (size_t)row * ldc + col0;
                *(u32x4*)(rp) = pack8(a0, a1); *(u32x4*)(rp + 128) = pack8(b0, b1);
                if (ssq) { float s = sumsq8(a0, a1); if (!only0) s += sumsq8(b0, b1);
                    s += __shfl_xor(s, 16); s += __shfl_xor(s, 32); if (fq == 0) ssq_add(ssq + row, s); }
            }
    }
};
template <int ACT> struct EpiRowScale {
    static constexpr bool PERM = true, AFTER_DRAIN = false, MIDK = false;
    bf16_t* O; int ldc; const u64* ssq; float inv_n;
    static __device__ __forceinline__ float act(float v) {
        if (ACT == 1) return __builtin_amdgcn_rcpf(1.0f + __expf(-v));
        if (ACT == 2) { const float r = fmaxf(v, 0.f); return r * r; }
        return v; }
    __device__ __forceinline__ void operator()(const f32x4 (&acc)[2][2][4][2], const Unit& u, int wr, int wc, int fr, int fq) const {
        const int row0 = u.pm * 256 + wr * 64 + fr, col0 = u.pn * 256 + wc * 32 + 8 * fq;
#pragma unroll
        for (int ai = 0; ai < 2; ++ai)
#pragma unroll
            for (int m = 0; m < 4; ++m) {
                const int row = row0 + ai * 128 + m * 16;
                const float rs = rs_of(ssq[row], inv_n);
                bf16_t* rp = O + (size_t)row * ldc + col0;
#pragma unroll
                for (int bj = 0; bj < 2; ++bj) { f32x4 v0 = acc[ai][bj][m][0] * rs, v1 = acc[ai][bj][m][1] * rs;
#pragma unroll
                    for (int e = 0; e < 4; ++e) { v0[e] = act(v0[e]); v1[e] = act(v1[e]); }
                    *(u32x4*)(rp + bj * 128) = pack8(v0, v1); }
            }
    }
};
struct EpiMixK {
    static constexpr bool PERM = true, AFTER_DRAIN = false, MIDK = true;
    bf16_t* Mb; const bf16_t* GG;
    __device__ __forceinline__ void mid(f32x4 (&acc)[2][2][4][2], const Unit& u, int wr, int wc, int fr, int fq) const {
        const int row0 = u.pm * 256 + wr * 64 + fr, col0 = u.pn * 256 + wc * 32 + 8 * fq;
#pragma unroll
        for (int ai = 0; ai < 2; ++ai)
#pragma unroll
            for (int m = 0; m < 4; ++m) {
                const bf16_t* gp = GG + (size_t)(row0 + ai * 128 + m * 16) * 2048 + col0;
#pragma unroll
                for (int bj = 0; bj < 2; ++bj) { f32x4 f0, f1, a0, a1; unpack8(*(const u32x4*)(gp + bj * 128), f0, f1); unpack8(*(const u32x4*)(gp + 1024 + bj * 128), a0, a1);
#pragma unroll
                    for (int e = 0; e < 4; ++e) { acc[ai][bj][m][0][e] *= f0[e] * __builtin_amdgcn_rcpf(fmaxf(a0[e], 1e-30f)); acc[ai][bj][m][1][e] *= f1[e] * __builtin_amdgcn_rcpf(fmaxf(a1[e], 1e-30f)); } }
                asm volatile("" ::: "memory");
            }
    }
    __device__ __forceinline__ void operator()(const f32x4 (&acc)[2][2][4][2], const Unit& u, int wr, int wc, int fr, int fq) const {
        const int row0 = u.pm * 256 + wr * 64 + fr, col0 = u.pn * 256 + wc * 32 + 8 * fq;
#pragma unroll
        for (int ai = 0; ai < 2; ++ai)
#pragma unroll
            for (int m = 0; m < 4; ++m) {
                const int row = row0 + ai * 128 + m * 16;
                const bf16_t* gp = GG + (size_t)row * 2048 + 1024 + col0; bf16_t* mp = Mb + (size_t)row * 1024 + col0;
#pragma unroll
                for (int bj = 0; bj < 2; ++bj) { f32x4 a0, a1; unpack8(*(const u32x4*)(gp + bj * 128), a0, a1);
#pragma unroll
                    for (int e = 0; e < 4; ++e) { a0[e] = fmaxf(a0[e], 1e-30f); a1[e] = fmaxf(a1[e], 1e-30f); }
                    *(u32x4*)(mp + bj * 128) = pack8(acc[ai][bj][m][0] * a0, acc[ai][bj][m][1] * a1); }
                asm volatile("" ::: "memory");
            }
    }
};
template <bool RES_BF16, bool WR_AB, bool WR_F32> struct EpiResid {
    static constexpr bool PERM = true, AFTER_DRAIN = false, MIDK = false;
    const float* res0; const float* res1; float* out; bf16_t* ab; u64* ssq;
    __device__ __forceinline__ void operator()(const f32x4 (&acc)[2][2][4][2], const Unit& u, int wr, int wc, int fr, int fq) const {
        const int row0 = u.pm * 256 + wr * 64 + fr, col0 = u.pn * 256 + wc * 32 + 8 * fq;
        const float* rbase = (u.pm * 256 < TP) ? res0 : (res1 - (size_t)TP * 1024);
#pragma unroll
        for (int ai = 0; ai < 2; ++ai)
#pragma unroll
            for (int m = 0; m < 4; ++m) {
                const int row = row0 + ai * 128 + m * 16;
                const size_t off = (size_t)row * 1024 + col0;
                float s = 0.f;
#pragma unroll
                for (int bj = 0; bj < 2; ++bj) {
                    f32x4 r0, r1;
                    if (RES_BF16) unpack8(*(const u32x4*)(ab + off + bj * 128), r0, r1);
                    else { r0 = *(const f32x4*)(rbase + off + bj * 128); r1 = *(const f32x4*)(rbase + off + bj * 128 + 4); }
                    const f32x4 v0 = r0 + acc[ai][bj][m][0], v1 = r1 + acc[ai][bj][m][1];
                    if (WR_F32) { *(f32x4*)(out + off + bj * 128) = v0; *(f32x4*)(out + off + bj * 128 + 4) = v1; }
                    if (WR_AB) { *(u32x4*)(ab + off + bj * 128) = pack8(v0, v1); s += sumsq8(v0, v1); } }
                if (WR_AB) { if (ssq) { s += __shfl_xor(s, 16); s += __shfl_xor(s, 32); if (fq == 0) ssq_add(ssq + row, s); } }
                asm volatile("" ::: "memory");
            }
    }
};
struct Args { const float* in[16]; float* out; unsigned char* ws; int ph_lo, ph_hi; };
__device__ __forceinline__ float wave_sum(float v) {
#pragma unroll
    for (int o = 1; o < 64; o <<= 1) v += __shfl_xor(v, o);
    return v;
}
#define LDS_WAIT() asm volatile("s_waitcnt lgkmcnt(0)" ::: "memory")

__device__ __forceinline__ void tr_item(const float* __restrict__ W, int ldw, int col0, int K, const float* __restrict__ gain, bf16_t* __restrict__ WT, int ldt, int kofs, int row0, int nblk, LAS float* scr, int item, int lane) {
    const int kb = item / nblk, nb = item % nblk, k0 = 64 * kb, n0 = 32 * nb;
#pragma unroll 8
    for (int i = 0; i < 32; ++i) { const int kk = 2 * i + (lane >> 5); const float g = gain ? gain[k0 + kk] : 1.0f;
        scr[kk * 33 + (lane & 31)] = W[(size_t)(k0 + kk) * ldw + col0 + n0 + (lane & 31)] * g; }
    LDS_WAIT(); asm volatile("" ::: "memory");
    const int c = lane & 7;
#pragma unroll
    for (int j = 0; j < 4; ++j) { const int n = (lane >> 3) + 8 * j; const LAS float* s = scr + (8 * c) * 33 + n;
        u32x4 o; o.x = cvt_pk(s[0 * 33], s[1 * 33]); o.y = cvt_pk(s[2 * 33], s[3 * 33]); o.z = cvt_pk(s[4 * 33], s[5 * 33]); o.w = cvt_pk(s[6 * 33], s[7 * 33]);
        *(u32x4*)(WT + (size_t)(row0 + n0 + n) * ldt + kofs + k0 + 8 * c) = o; }
    LDS_WAIT(); asm volatile("" ::: "memory");
}
__device__ __forceinline__ void tr_piece(const float* W, int ldw, int col0, int ncols, int K, const float* gain, bf16_t* WT, int row0, LAS float* scr, int gw, int NGW, int lane, int ldt = 0, int kofs = 0) {
    const int nblk = ncols / 32, nitems = (K / 64) * nblk;
    for (int it = gw; it < nitems; it += NGW) tr_item(W, ldw, col0, K, gain, WT, ldt ? ldt : K, kofs, row0, nblk, scr, it, lane);
}

__device__ __forceinline__ void p0_prologue(const Args& a, unsigned char* lds_g, const int wv) {
    LAS unsigned char* lds = (LAS unsigned char*)lds_g;
    const int tid = ltid(wv), lane = tid & 63, wave = tid >> 6, G = lgdim();
    const int gw = lbid() * 8 + wave, NGW = G * 8, gt = lbid() * 512 + tid, NGT = G * 512;
    unsigned char* ws = a.ws;
    u64* ssq = (u64*)(ws + WS_SSQ);
    for (int i = gt + T; i < 8 * T; i += NGT) ssq[i] = 0ull;
    bf16_t* AB = (bf16_t*)(ws + WS_AB);
    for (int m = gw; m < T; m += NGW) {
        const float* xr = (m < TP) ? a.in[0] + (size_t)m * DM : a.in[1] + (size_t)(m - TP) * DM;
        f32x4 v[4]; float s = 0.f;
#pragma unroll
        for (int j = 0; j < 4; ++j) { v[j] = ((const f32x4*)xr)[lane + 64 * j]; s += (v[j][0] * v[j][0] + v[j][1] * v[j][1]) + (v[j][2] * v[j][2] + v[j][3] * v[j][3]); }
        s = wave_sum(s);
        u32x2* o8 = (u32x2*)(AB + (size_t)m * DM);
#pragma unroll
        for (int j = 0; j < 4; ++j) { u32x2 w; w.x = cvt_pk(v[j][0], v[j][1]); w.y = cvt_pk(v[j][2], v[j][3]); o8[lane + 64 * j] = w; }
        if (lane == 0) ssq[m] = __float2ull_rn(s * 4294967296.0f);
    }
    LAS float* scr = (LAS float*)(lds + wave * 16384);
    for (int l = 0; l < 2; ++l) {
        unsigned char* wl = ws + WS_W + (size_t)l * W_LAYER;
        const float* w_in = a.in[3] + (size_t)l * DM * INW; const float* g1 = a.in[2] + l * DM;
        tr_piece(w_in, INW, 512, 256, DM, g1, (bf16_t*)(wl + WO_IN1), 1024, scr, gw, NGW, lane);
        tr_piece(w_in, INW, 768, 160, DM, g1, (bf16_t*)(wl + WO_IN1), 1280, scr, gw, NGW, lane);
        tr_piece(w_in, INW, 928, 2048, DM, g1, (bf16_t*)(wl + WO_G), 0, scr, gw, NGW, lane);
        tr_piece(a.in[5] + (size_t)l * 256 * 768, 768, 0, 768, 256, a.in[4] + l * 256, (bf16_t*)(wl + WO_UQ), 0, scr, gw, NGW, lane);
        tr_piece(a.in[7] + (size_t)l * 128 * 1024, 1024, 0, 1024, 128, a.in[6] + l * 128, (bf16_t*)(wl + WO_UKV), 0, scr, gw, NGW, lane);
        tr_piece(a.in[10] + (size_t)l * 512 * 1024, 1024, 0, 1024, 512, nullptr, (bf16_t*)(wl + WO_OF), 0, scr, gw, NGW, lane, 1024, 0);
        tr_piece(a.in[11] + (size_t)l * 512 * 1024, 1024, 0, 1024, 512, nullptr, (bf16_t*)(wl + WO_OF), 0, scr, gw, NGW, lane, 1024, 512);
        tr_piece(a.in[12] + (size_t)l * 1024 * 1024, 1024, 0, 1024, 1024, nullptr, (bf16_t*)(wl + WO_OUT), 0, scr, gw, NGW, lane);
        tr_piece(a.in[14] + (size_t)l * 1024 * 4096, 4096, 0, 4096, 1024, a.in[13] + l * DM, (bf16_t*)(wl + WO_UP), 0, scr, gw, NGW, lane);
        tr_piece(a.in[15] + (size_t)l * 4096 * 1024, 1024, 0, 1024, 4096, nullptr, (bf16_t*)(wl + WO_DN), 0, scr, gw, NGW, lane);
        u32x4* z = (u32x4*)((bf16_t*)(wl + WO_IN1) + (size_t)1440 * DM);
        for (int i = gt; i < 96 * DM / 8; i += NGT) z[i] = (u32x4){0u, 0u, 0u, 0u};
    }
    {
        bf16_t* m1a = (bf16_t*)(ws + WS_M1A); bf16_t* m1b = (bf16_t*)(ws + WS_M1B); bf16_t* m2a = (bf16_t*)(ws + WS_M2A); bf16_t* m2b = (bf16_t*)(ws + WS_M2B);
        for (int i = gt; i < 64 * 64 + 256 * 256; i += NGT) {
            const bool big = i >= 64 * 64; const int j = big ? i - 64 * 64 : i; const int N1 = big ? 128 : 32, W2 = 2 * N1;
            const int r = j / W2, c = j % W2, pp = r / N1, k1 = r % N1, p = c / N1, n1 = c % N1;
            const float ang = 2.0f * (float)((n1 * k1) % N1) / (float)N1; const float cs = cospif(ang), sn = sinpif(ang);
            const float sc = big ? 0.0078125f : 0.02209708691207961f;
            const float v = (pp == p) ? cs : (pp == 0 ? sn : -sn);
            (big ? m1b : m1a)[j] = (bf16_t)(cvt_pk(v * sc, 0.f) & 0xffffu);
        }
        for (int i = gt; i < 32 * 64 * 128 + 128 * 128 * 256; i += NGT) {
            const bool big = i >= 32 * 64 * 128; const int j = big ? i - 32 * 64 * 128 : i;
            const int N1 = big ? 128 : 32, N2 = big ? 128 : 64, S = N1 * N2, W2 = 2 * N2;
            const int c = j % W2, k2 = (j / W2) % N2, k1 = j / (W2 * N2), p = c / N2, n2 = c % N2;
            const int mm = (n2 * (k1 + N1 * k2)) % S; const float ang = 2.0f * (float)mm / (float)S;
            const float v = p ? sinpif(ang) : cospif(ang);
            (big ? m2b : m2a)[j] = (bf16_t)(cvt_pk(v, 0.f) & 0xffffu);
        }
        float2* rt = (float2*)(ws + WS_ROPE);
        for (int i = gt; i < 16384 * 16; i += NGT) { const int pos = i >> 4, f = i & 15;
            const float inv = powf(10000.0f, -(float)(2 * f) / 32.0f); const float ang = (float)pos * inv; float s, c; sincosf(ang, &s, &c); rt[i] = make_float2(c, s); }
    }
    __syncthreads();
    {
        LAS float* cs = (LAS float*)lds; LAS float* sn = cs + 128; LAS float* wl_s = sn + 128;
        if (tid < 128) { cs[tid] = cospif(2.0f * (float)tid / 128.0f); sn[tid] = sinpif(2.0f * (float)tid / 128.0f); }
        for (int it = lbid(); it < 2 * 128 * 4; it += G) {
            const int l = it >> 9, db = (it >> 2) & 127, g = it & 3, d0 = db * 8;
            const float* w_in = a.in[3] + (size_t)l * DM * INW; const float* g1 = a.in[2] + l * DM;
            __syncthreads();
            for (int i = tid; i < 1024; i += 512) wl_s[i] = w_in[(size_t)(d0 + (i >> 7)) * INW + g * 128 + (i & 127)];
            __syncthreads();
            const int j = tid & 127, p = (tid >> 7) & 1, dh = tid >> 8;
            float acc0 = 0.f, acc1 = 0.f, acc2 = 0.f, acc3 = 0.f;
            for (int c = 0; c < 128; ++c) { const int idx = (c * j) & 127; const float w = p ? -sn[idx] : cs[idx];
                acc0 += wl_s[(dh * 4 + 0) * 128 + c] * w; acc1 += wl_s[(dh * 4 + 1) * 128 + c] * w; acc2 += wl_s[(dh * 4 + 2) * 128 + c] * w; acc3 += wl_s[(dh * 4 + 3) * 128 + c] * w; }
            const float sc = 0.08838834764831845f; const int dd = d0 + dh * 4;
            u32x2 o; o.x = cvt_pk(acc0 * sc * g1[dd], acc1 * sc * g1[dd + 1]); o.y = cvt_pk(acc2 * sc * g1[dd + 2], acc3 * sc * g1[dd + 3]);
            bf16_t* dst = (bf16_t*)(ws + WS_W + (size_t)l * W_LAYER + WO_IN1) + (size_t)(p * 512 + g * 128 + j) * DM + dd;
            *(u32x2*)dst = o;
        }
        __syncthreads();
    }
}

template <bool WHICH> __device__ __forceinline__ const bf16_t* fin_src(const bf16_t* Qb, const bf16_t* KV, const bf16_t* CKV, int token, int h, int pc) {
    return !WHICH ? Qb + (size_t)token * 768 + h * 96 + pc * 32 : (pc < 2 ? KV + (size_t)token * 1024 + h * 128 + pc * 32 : CKV + (size_t)token * 256 + 128);
}
__device__ __forceinline__ void fin_math(const u32x4 (&w)[4], const float (&g)[32], const float2* __restrict__ rt, int token, int part, u32x4 (&o)[4]) {
    float v[32];
#pragma unroll
    for (int j = 0; j < 4; ++j) { v[8*j] = bf_lo(w[j].x); v[8*j+1] = bf_hi(w[j].x); v[8*j+2] = bf_lo(w[j].y); v[8*j+3] = bf_hi(w[j].y); v[8*j+4] = bf_lo(w[j].z); v[8*j+5] = bf_hi(w[j].z); v[8*j+6] = bf_lo(w[j].w); v[8*j+7] = bf_hi(w[j].w); }
    float ss = 0.f;
#pragma unroll
    for (int d = 0; d < 32; ++d) ss += v[d] * v[d];
    if (part == 3) ss = 0.f;
    ss += __shfl_xor(ss, 1); ss += __shfl_xor(ss, 2);
    const float r = 1.0f / sqrtf(ss * (1.0f / 96.0f) + EPS);
#pragma unroll
    for (int d = 0; d < 32; ++d) v[d] = v[d] * r * g[d];
    if (part == 2) { const int pos = token < TP ? (token & 2047) : token - TP;
#pragma unroll
        for (int f = 0; f < 16; ++f) { const float2 cs = rt[pos * 16 + f]; const float x1 = v[f], x2 = v[16 + f]; v[f] = x1 * cs.x - x2 * cs.y; v[16 + f] = x2 * cs.x + x1 * cs.y; } }
#pragma unroll
    for (int j = 0; j < 4; ++j) { o[j].x = cvt_pk(v[8*j], v[8*j+1]); o[j].y = cvt_pk(v[8*j+2], v[8*j+3]); o[j].z = cvt_pk(v[8*j+4], v[8*j+5]); o[j].w = cvt_pk(v[8*j+6], v[8*j+7]); }
}
template <bool WHICH> __device__ __forceinline__ void finalize_pass(const Args& a, int l, const int wv) {
    unsigned char* ws = a.ws;
    bf16_t* Qb = (bf16_t*)(ws + WS_QB); bf16_t* Kb = (bf16_t*)(ws + WS_KB); const bf16_t* KV = (const bf16_t*)(ws + WS_KVRAW); const bf16_t* CKV = (const bf16_t*)(ws + WS_CKV);
    const float2* rt = (const float2*)(ws + WS_ROPE);
    const int NGT = lgdim() * 512, gt = lbid() * 512 + ltid(wv), part = gt & 3, pc = part < 3 ? part : 2;
    static_assert((T * NH * 4) % (2 * 256 * 512) == 0, "uniform trip count");
    float g[32];
    { const float* gg = (WHICH ? a.in[9] : a.in[8]) + l * DQK + pc * 32;
#pragma unroll
      for (int d = 0; d < 32; ++d) g[d] = WHICH ? gg[d] : gg[d] * 0.14724448646421766f; }
    bf16_t* dst = WHICH ? Kb : Qb;
    for (int i = gt; i < T * NH * 4; i += 2 * NGT) {
        const int t0 = (i >> 2) >> 3, h0 = (i >> 2) & 7, i1 = i + NGT, t1 = (i1 >> 2) >> 3, h1 = (i1 >> 2) & 7;
        const u32x4* s0 = (const u32x4*)fin_src<WHICH>(Qb, KV, CKV, t0, h0, pc); const u32x4* s1 = (const u32x4*)fin_src<WHICH>(Qb, KV, CKV, t1, h1, pc);
        u32x4 w0[4], w1[4], o0[4], o1[4];
#pragma unroll
        for (int j = 0; j < 4; ++j) { w0[j] = s0[j]; w1[j] = s1[j]; }
        fin_math(w0, g, rt, t0, part, o0); fin_math(w1, g, rt, t1, part, o1);
        if (part < 3) { u32x4* d0 = (u32x4*)(dst + (size_t)t0 * 768 + h0 * 96 + part * 32); u32x4* d1 = (u32x4*)(dst + (size_t)t1 * 768 + h1 * 96 + part * 32);
#pragma unroll
            for (int j = 0; j < 4; ++j) { d0[j] = o0[j]; d1[j] = o1[j]; } }
    }
}
__device__ __forceinline__ void finalize_qk(const Args& a, int l, const int wv) { finalize_pass<true>(a, l, wv); }

__device__ __forceinline__ int crow(int r, int hi) { return (r & 3) + 8 * (r >> 2) + 4 * hi; }
typedef short v4i16_t __attribute__((ext_vector_type(4)));
__device__ __forceinline__ s16x4 vtr(const LAS char* p) { return __builtin_bit_cast(s16x4, __builtin_amdgcn_ds_read_tr16_b64_v4i16((LAS v4i16_t*)p)); }
template <int KC> __device__ __forceinline__ void seqmix_load(u32x4 (&st)[KC / 32], const bf16_t* in, size_t in_stride, int tid) {
    constexpr int KH = KC / 2;
#pragma unroll
    for (int i = 0; i < KC / 32; ++i) { const int id = tid + 512 * i, row = id >> 4, ch = id & 15, p = row / KH, n = row % KH;
        st[i] = *(const u32x4*)(in + (size_t)n * in_stride + p * 512 + ch * 8); }
}
template <int MOUT, int KC, int MH, int ISTR, int OSTR, class Desc>
__device__ __forceinline__ void seqmix_run(unsigned char* lds_g, const Desc D, int first, int step, int nunits, const int wv) {
    constexpr size_t in_stride = ISTR, out_stride = OSTR;
    constexpr int PITCH = 320, NLD = KC / 32, NRB = MOUT / 32, WR = NRB < 8 ? NRB : 8, WCN = 8 / WR, CPW = 4 / WCN, NKS = KC / 16;
    LAS char* lds = (LAS char*)lds_g;
    const int tid = ltid(wv), lane = tid & 63, wid = tid >> 6, r32 = lane & 31, hi = lane >> 5;
    const int rb = wid % WR, cg0 = (wid / WR) * CPW;
    const LAS char* vb = lds + (8 * hi + ((lane >> 2) & 3)) * PITCH + (16 * ((lane >> 4) & 1) + 4 * (lane & 3)) * 2;
    u32x4 st[NLD];
    int u = first;
    if (u < nunits) { const bf16_t* mat; const bf16_t* in; bf16_t* out; D(u, mat, in, out); seqmix_load<KC>(st, in, in_stride, tid); }
    while (u < nunits) {
        const bf16_t* mat; const bf16_t* in; bf16_t* out; D(u, mat, in, out);
        bf16x8 af[NKS];
#pragma unroll
        for (int ks = 0; ks < NKS; ++ks) af[ks] = *(const bf16x8*)(mat + (size_t)(rb * 32 + r32) * KC + ks * 16 + hi * 8);
        __syncthreads();
#pragma unroll
        for (int i = 0; i < NLD; ++i) { const int id = tid + 512 * i, row = id >> 4, ch = id & 15; *(LAS u32x4*)(lds + row * PITCH + ch * 16) = st[i]; }
        __syncthreads();
        const int un = u + step;
        if (un < nunits) { const bf16_t* m2; const bf16_t* in2; bf16_t* o2; D(un, m2, in2, o2); seqmix_load<KC>(st, in2, in_stride, tid); }
        f32x16 acc[CPW];
#pragma unroll
        for (int c = 0; c < CPW; ++c) acc[c] = (f32x16){};
#pragma unroll
        for (int ks = 0; ks < NKS; ++ks)
#pragma unroll
            for (int c = 0; c < CPW; ++c) {
                const s16x4 lo = vtr(vb + ks * 16 * PITCH + (cg0 + c) * 64), h4 = vtr(vb + ks * 16 * PITCH + 4 * PITCH + (cg0 + c) * 64);
                const bf16x8 b = (bf16x8){lo[0], lo[1], lo[2], lo[3], h4[0], h4[1], h4[2], h4[3]};
                acc[c] = __builtin_amdgcn_mfma_f32_32x32x16_bf16(af[ks], b, acc[c], 0, 0, 0);
            }
        { bf16_t* ob = out + (size_t)(((rb * 32) % MH) + 4 * hi) * out_stride + ((rb * 32) / MH) * 512 + cg0 * 32 + r32;
#pragma unroll
          for (int c = 0; c < CPW; ++c)
#pragma unroll
            for (int r = 0; r < 16; ++r) ob[(size_t)((r & 3) + 8 * (r >> 2)) * out_stride + c * 32] = (bf16_t)(cvt_pk(acc[c][r], 0.f) & 0xffffu); }
        u = un;
    }
    __syncthreads();
}
struct DescS1S { bf16_t* VC; const bf16_t* m; __device__ __forceinline__ void operator()(int u, const bf16_t*& mat, const bf16_t*& in, bf16_t*& out) const {
    const int chunk = u & 3, n2 = u >> 2; bf16_t* p = VC + (size_t)(TP + n2) * 1024 + chunk * 128; mat = m; in = p; out = p; } };
struct DescS1P { bf16_t* VC; const bf16_t* m; __device__ __forceinline__ void operator()(int u, const bf16_t*& mat, const bf16_t*& in, bf16_t*& out) const {
    const int chunk = u & 3, n2 = (u >> 2) & 63, b = u >> 8; bf16_t* p = VC + (size_t)(b * 2048 + n2) * 1024 + chunk * 128; mat = m; in = p; out = p; } };
struct DescS2S { const bf16_t* T1; bf16_t* FA; const bf16_t* m; __device__ __forceinline__ void operator()(int u, const bf16_t*& mat, const bf16_t*& in, bf16_t*& out) const {
    const int chunk = u & 3, k1 = u >> 2; mat = m + (size_t)k1 * 128 * 256; in = T1 + (size_t)(TP + 128 * k1) * 1024 + chunk * 128; out = FA + (size_t)(TP + k1) * 1024 + chunk * 128; } };
struct DescS2P { const bf16_t* T1; bf16_t* FA; const bf16_t* m; __device__ __forceinline__ void operator()(int u, const bf16_t*& mat, const bf16_t*& in, bf16_t*& out) const {
    const int chunk = u & 3, k1 = (u >> 2) & 31, b = u >> 7; mat = m + (size_t)k1 * 64 * 128; in = T1 + (size_t)(b * 2048 + 64 * k1) * 1024 + chunk * 128; out = FA + (size_t)(b * 2048 + k1) * 1024 + chunk * 128; } };
__device__ __forceinline__ void fourier_stage1(const Args& a, unsigned char* lds, const int wv) {
    unsigned char* ws = a.ws; bf16_t* VC = (bf16_t*)(ws + WS_VC);
    seqmix_run<256, 256, 128, 128 * 1024, 128 * 1024>(lds, DescS1S{VC, (const bf16_t*)(ws + WS_M1B)}, lbid(), lgdim(), 512, wv);
    seqmix_run<64, 64, 32, 64 * 1024, 64 * 1024>(lds, DescS1P{VC, (const bf16_t*)(ws + WS_M1A)}, lbid(), lgdim(), 8192, wv);
}
__device__ __forceinline__ void fourier_stage2(const Args& a, unsigned char* lds, const int wv) {
    unsigned char* ws = a.ws; const bf16_t* T1 = (const bf16_t*)(ws + WS_VC); bf16_t* FA = (bf16_t*)(ws + WS_FA);
    seqmix_run<128, 256, 128, 1024, 128 * 1024>(lds, DescS2S{T1, FA, (const bf16_t*)(ws + WS_M2B)}, lbid(), lgdim(), 512, wv);
    seqmix_run<64, 128, 64, 1024, 32 * 1024>(lds, DescS2P{T1, FA, (const bf16_t*)(ws + WS_M2A)}, lbid(), lgdim(), 4096, wv);
}

namespace att {
constexpr int NW = 8, QBLK = 32, KVBLK = 64;
constexpr int LDQ = 768, LDK = 768, LDV = 1024, LDO = 1024;
constexpr float SCALE = 0.10206207261596575f;
constexpr float THR = 8.f;
constexpr size_t SHM_V = 64 * 128 * 2, SHM_K = 64 * 256;
#define KSWZ(row, colB) ((row) * 256 + ((colB) ^ (((row) & 7) << 4)))
#define SBAR() __builtin_amdgcn_sched_barrier(0)
#define MX3(a, b, c) __builtin_fmaxf(__builtin_fmaxf((a), (b)), (c))
template <bool FIRST> __device__ __forceinline__ void partialSM(f32x16& p0, f32x16& p1, float& m_reg, f32x16& negm, float& alpha) {
  constexpr float THR2 = THR * 1.4426950408889634f;
  float a = MX3(p0[0], p0[1], p1[0]), b = MX3(p0[2], p0[3], p1[1]); a = MX3(a, p1[2], p1[3]);
#pragma unroll
  for (int r = 4; r < 16; r += 4) { a = MX3(a, p0[r], p0[r + 1]); b = MX3(b, p0[r + 2], p0[r + 3]); a = MX3(a, p1[r], p1[r + 1]); b = MX3(b, p1[r + 2], p1[r + 3]); }
  float pmax = __builtin_fmaxf(a, b);
  { auto rr = __builtin_amdgcn_permlane32_swap(__float_as_uint(pmax), __float_as_uint(pmax), false, false);
    pmax = __builtin_fmaxf(__uint_as_float(rr[0]), __uint_as_float(rr[1])); }
  alpha = 1.f;
  if (FIRST || !__builtin_expect(__all(pmax <= THR2), 1)) {
    const float dl = FIRST ? pmax : __builtin_fmaxf(pmax, 0.f);
    m_reg += dl;
#pragma unroll
    for (int r = 0; r < 16; ++r) { p0[r] -= dl; p1[r] -= dl; }
#pragma unroll
    for (int r = 0; r < 16; ++r) negm[r] = -m_reg;
    if (!FIRST) alpha = __builtin_amdgcn_exp2f(-dl);
  }
#pragma unroll
  for (int r = 0; r < 16; ++r) p0[r] = __builtin_amdgcn_exp2f(p0[r]);
}
__device__ __forceinline__ void finishSM(f32x16& p0, f32x16& p1, float alpha, float& l_reg, bf16x8& pa0, bf16x8& pa1, bf16x8& pa2, bf16x8& pa3) {
#pragma unroll
  for (int r = 0; r < 16; ++r) p1[r] = __builtin_amdgcn_exp2f(p1[r]);
  float ps = 0;
#pragma unroll
  for (int r = 0; r < 16; ++r) ps += p0[r];
#pragma unroll
  for (int r = 0; r < 16; ++r) ps += p1[r];
  { auto rr = __builtin_amdgcn_permlane32_swap(__float_as_uint(ps), __float_as_uint(ps), false, false);
    ps = __uint_as_float(rr[0]) + __uint_as_float(rr[1]); }
  l_reg = l_reg * alpha + ps;
#define PK4(P, BASE, OUT) do { unsigned a0 = cvt_pk(P[BASE + 0], P[BASE + 1]), a1 = cvt_pk(P[BASE + 2], P[BASE + 3]);   \
    unsigned b0 = cvt_pk(P[BASE + 4], P[BASE + 5]), b1 = cvt_pk(P[BASE + 6], P[BASE + 7]);                              \
    auto r0 = __builtin_amdgcn_permlane32_swap(a0, b0, false, false); auto r1 = __builtin_amdgcn_permlane32_swap(a1, b1, false, false); \
    u32x4 w = {r0[0], r1[0], r0[1], r1[1]}; OUT = *reinterpret_cast<bf16x8*>(&w); } while (0)
  PK4(p0, 0, pa0); PK4(p0, 8, pa1); PK4(p1, 0, pa2); PK4(p1, 8, pa3);
#undef PK4
}
__device__ __forceinline__ void qkt(f32x16& p0, f32x16& p1, const char* Ks, const bf16x8* qr, const f32x16& negm, int r32, int hi) {
#pragma unroll
  for (int d0 = 0; d0 < 6; ++d0) { int cb = (d0 * 16 + hi * 8) * 2;
    bf16x8 b0 = *reinterpret_cast<const bf16x8*>(Ks + KSWZ(r32, cb));
    bf16x8 b1 = *reinterpret_cast<const bf16x8*>(Ks + KSWZ(32 + r32, cb));
    p0 = __builtin_amdgcn_mfma_f32_32x32x16_bf16(b0, qr[d0], d0 == 0 ? negm : p0, 0, 0, 0);
    p1 = __builtin_amdgcn_mfma_f32_32x32x16_bf16(b1, qr[d0], d0 == 0 ? negm : p1, 0, 0, 0); }
}
__device__ __forceinline__ int v_st(int k, int c) { const int kk = (k & ~0xC) | ((k & 4) << 1) | ((k & 8) >> 1); return ((kk >> 3) * 4 + (c >> 5)) * 512 + ((kk & 7) * 32 + (c & 31)) * 2; }
__device__ __forceinline__ int v_rd_base(int lane) { return ((lane & 3) << 3) | (((lane >> 2) & 3) << 6) | (((lane >> 4) & 1) << 5) | (((lane >> 5) & 1) << 8); }
constexpr int v_rd_off(int d0, int ks, int half) { return d0 * 512 + ks * 4096 + half * 2048; }
template <int OFF> __device__ __forceinline__ s16x4 tr_read(int vb) {
  s16x4 r; asm volatile("ds_read_b64_tr_b16 %0, %1 offset:%2" : "=&v"(r) : "v"(vb), "i"(OFF) : "memory"); return r;
}
template <int D0> __device__ __forceinline__ void pv_one(f32x16& od, int vb, bf16x8 pa0, bf16x8 pa1, bf16x8 pa2, bf16x8 pa3) {
  const s16x4 l0 = tr_read<v_rd_off(D0, 0, 0)>(vb), h0 = tr_read<v_rd_off(D0, 0, 1)>(vb), l1 = tr_read<v_rd_off(D0, 1, 0)>(vb), h1 = tr_read<v_rd_off(D0, 1, 1)>(vb);
  const s16x4 l2 = tr_read<v_rd_off(D0, 2, 0)>(vb), h2 = tr_read<v_rd_off(D0, 2, 1)>(vb), l3 = tr_read<v_rd_off(D0, 3, 0)>(vb), h3 = tr_read<v_rd_off(D0, 3, 1)>(vb);
  asm volatile("s_waitcnt lgkmcnt(0)" ::: "memory"); SBAR();
#define PK(L, H) (bf16x8){L[0], L[1], L[2], L[3], H[0], H[1], H[2], H[3]}
  od = __builtin_amdgcn_mfma_f32_32x32x16_bf16(pa0, PK(l0, h0), od, 0, 0, 0);
  od = __builtin_amdgcn_mfma_f32_32x32x16_bf16(pa1, PK(l1, h1), od, 0, 0, 0);
  od = __builtin_amdgcn_mfma_f32_32x32x16_bf16(pa2, PK(l2, h2), od, 0, 0, 0);
  od = __builtin_amdgcn_mfma_f32_32x32x16_bf16(pa3, PK(l3, h3), od, 0, 0, 0);
#undef PK
}
__device__ __forceinline__ void pv_d0(f32x16* o, int vb, bf16x8 pa0, bf16x8 pa1, bf16x8 pa2, bf16x8 pa3) {
  pv_one<0>(o[0], vb, pa0, pa1, pa2, pa3); pv_one<1>(o[1], vb, pa0, pa1, pa2, pa3);
}
__device__ __forceinline__ void glds16(const void* gsrc, unsigned lds_dst) { unsigned keep;
  asm volatile("s_mov_b32 %0, m0\n\ts_mov_b32 m0, %2\n\ts_nop 0\n\tglobal_load_lds_dwordx4 %1, off\n\ts_mov_b32 m0, %0" : "=&s"(keep) : "v"(gsrc), "s"(lds_dst) : "memory"); }
#define WAIT_BAR(N) asm volatile("s_waitcnt vmcnt(" #N ") lgkmcnt(0)\n\ts_barrier" ::: "memory")
constexpr int KSLOT = 16384, VSLOT = 8192, LDS_KR = 0, LDS_VR = 4 * KSLOT, LDS_WSF = LDS_VR + 4 * VSLOT;
constexpr int v_rd_off2(int d0, int ks, int half) { return d0 * 512 + ks * 2048 + half * 1024; }
__device__ __forceinline__ void pv2(f32x16* o, int vb, bf16x8 pa0, bf16x8 pa1, bf16x8 pa2, bf16x8 pa3) {
  const s16x4 a0 = tr_read<v_rd_off2(0, 0, 0)>(vb), b0 = tr_read<v_rd_off2(0, 0, 1)>(vb), c0 = tr_read<v_rd_off2(1, 0, 0)>(vb), d0 = tr_read<v_rd_off2(1, 0, 1)>(vb);
  const s16x4 a1 = tr_read<v_rd_off2(0, 1, 0)>(vb), b1 = tr_read<v_rd_off2(0, 1, 1)>(vb), c1 = tr_read<v_rd_off2(1, 1, 0)>(vb), d1 = tr_read<v_rd_off2(1, 1, 1)>(vb);
  const s16x4 a2 = tr_read<v_rd_off2(0, 2, 0)>(vb), b2 = tr_read<v_rd_off2(0, 2, 1)>(vb), c2 = tr_read<v_rd_off2(1, 2, 0)>(vb), d2 = tr_read<v_rd_off2(1, 2, 1)>(vb);
  const s16x4 a3 = tr_read<v_rd_off2(0, 3, 0)>(vb), b3 = tr_read<v_rd_off2(0, 3, 1)>(vb), c3 = tr_read<v_rd_off2(1, 3, 0)>(vb), d3 = tr_read<v_rd_off2(1, 3, 1)>(vb);
  asm volatile("s_waitcnt lgkmcnt(0)" ::: "memory"); SBAR();
#define PK(L, H) (bf16x8){L[0], L[1], L[2], L[3], H[0], H[1], H[2], H[3]}
  o[0] = __builtin_amdgcn_mfma_f32_32x32x16_bf16(pa0, PK(a0, b0), o[0], 0, 0, 0);
  o[1] = __builtin_amdgcn_mfma_f32_32x32x16_bf16(pa0, PK(c0, d0), o[1], 0, 0, 0);
  o[0] = __builtin_amdgcn_mfma_f32_32x32x16_bf16(pa1, PK(a1, b1), o[0], 0, 0, 0);
  o[1] = __builtin_amdgcn_mfma_f32_32x32x16_bf16(pa1, PK(c1, d1), o[1], 0, 0, 0);
  o[0] = __builtin_amdgcn_mfma_f32_32x32x16_bf16(pa2, PK(a2, b2), o[0], 0, 0, 0);
  o[1] = __builtin_amdgcn_mfma_f32_32x32x16_bf16(pa2, PK(c2, d2), o[1], 0, 0, 0);
  o[0] = __builtin_amdgcn_mfma_f32_32x32x16_bf16(pa3, PK(a3, b3), o[0], 0, 0, 0);
  o[1] = __builtin_amdgcn_mfma_f32_32x32x16_bf16(pa3, PK(c3, d3), o[1], 0, 0, 0);
#undef PK
}
__device__ __forceinline__ void attn_unit(const bf16_t* __restrict__ Qb, const bf16_t* __restrict__ Kh, const bf16_t* __restrict__ Vh, bf16_t* __restrict__ Ob, int seq, char* lds, const int wv, const float* __restrict__ gq, const float2* __restrict__ rt, int pos0) {
  const int tid = ltid(wv), wid = wv, lane = tid & 63, r32 = lane & 31, hi = lane >> 5;
  const unsigned lds0 = (unsigned)(uintptr_t)lds;
  float* ws = (float*)(lds + LDS_WSF) + wid * 64; float* li_l = ws; float* al_l = ws + 32;
  float m_reg = 0.f, l_reg = 0; f32x16 o[2] = {}; f32x16 negm = {}; bf16x8 qr[6];
  const bf16_t* Qw = Qb + (long)(wid * QBLK + r32) * LDQ + hi * 8;
  __syncthreads();
  {
    float v[6][8]; float ss = 0.f;
#pragma unroll
    for (int d0 = 0; d0 < 6; ++d0) { const u32x4 w = *reinterpret_cast<const u32x4*>(Qw + d0 * 16);
      v[d0][0] = bf_lo(w.x); v[d0][1] = bf_hi(w.x); v[d0][2] = bf_lo(w.y); v[d0][3] = bf_hi(w.y); v[d0][4] = bf_lo(w.z); v[d0][5] = bf_hi(w.z); v[d0][6] = bf_lo(w.w); v[d0][7] = bf_hi(w.w);
#pragma unroll
      for (int j = 0; j < 8; ++j) ss += v[d0][j] * v[d0][j]; }
    ss += __shfl_xor(ss, 32);
    const float r = (1.0f / sqrtf(ss * (1.0f / 96.0f) + EPS));
#pragma unroll
    for (int d0 = 0; d0 < 6; ++d0)
#pragma unroll
      for (int j = 0; j < 8; ++j) v[d0][j] = v[d0][j] * r * gq[d0 * 16 + hi * 8 + j];
    const int pos = pos0 + wid * QBLK + r32;
#pragma unroll
    for (int j = 0; j < 8; ++j) { const float2 cs = rt[pos * 16 + hi * 8 + j]; const float x1 = v[4][j], x2 = v[5][j]; v[4][j] = x1 * cs.x - x2 * cs.y; v[5][j] = x2 * cs.x + x1 * cs.y; }
    constexpr float CQ = 0.14724448646421766f;
#pragma unroll
    for (int d0 = 0; d0 < 6; ++d0) { u32x4 w; w.x = cvt_pk(v[d0][0] * CQ, v[d0][1] * CQ); w.y = cvt_pk(v[d0][2] * CQ, v[d0][3] * CQ); w.z = cvt_pk(v[d0][4] * CQ, v[d0][5] * CQ); w.w = cvt_pk(v[d0][6] * CQ, v[d0][7] * CQ);
      qr[d0] = __builtin_bit_cast(bf16x8, w); }
  }
  const int kq = lane >> 4, kc0 = (lane & 15) ^ kq, kc1 = (lane & 15) ^ (4 + kq);
  const char* ksrc0 = (const char*)Kh + (size_t)(8 * wid + kq) * (LDK * 2) + (kc0 > 11 ? 11 : kc0) * 16;
  const char* ksrc1 = (const char*)Kh + (size_t)(8 * wid + 4 + kq) * (LDK * 2) + (kc1 > 11 ? 11 : kc1) * 16;
  const int vkk = 8 * wid + ((lane & 31) >> 2), vk = (vkk & ~0xC) | ((vkk & 4) << 1) | ((vkk & 8) >> 1);
  const char* vsrc = (const char*)Vh + (size_t)vk * (LDV * 2) + (32 * (lane >> 5) + 8 * (lane & 3)) * 2;
  const unsigned kdst = lds0 + LDS_KR + wid * 2048, vdst = lds0 + LDS_VR + wid * 1024;
#define DMA_K(t, slot) do { const size_t o_ = (size_t)(t) * (KVBLK * LDK * 2); const unsigned d_ = (unsigned)__builtin_amdgcn_readfirstlane(kdst + (slot) * KSLOT); glds16(ksrc0 + o_, d_); glds16(ksrc1 + o_, d_ + 1024u); } while (0)
#define DMA_V(t, slot) glds16(vsrc + (size_t)(t) * (KVBLK * LDV * 2), (unsigned)__builtin_amdgcn_readfirstlane(vdst + (slot) * VSLOT))
#define RESC(a) do { if (__any((a) < 1.f)) { if (hi == 0) al_l[r32] = (a); asm volatile("s_waitcnt lgkmcnt(0)" ::: "memory"); \
    _Pragma("unroll") for (int d = 0; d < 2; ++d) _Pragma("unroll") for (int r = 0; r < 16; ++r) o[d][r] *= al_l[crow(r, hi)]; } } while (0)
  const int vb0 = (int)lds0 + LDS_VR + v_rd_base(lane);
  f32x16 pA0, pA1, pB0, pB1; float alA, alB; bf16x8 pa0, pa1, pa2, pa3; const int NT = seq / KVBLK;
  DMA_K(0, 0); DMA_K(1, 1); DMA_V(0, 0);
  WAIT_BAR(0);
#define STEP(C0, C1, alC, P0, P1, alP, t) do { \
    SBAR(); qkt(C0, C1, lds + LDS_KR + ((t) & 3) * KSLOT, qr, negm, r32, hi); \
    finishSM(P0, P1, alP, l_reg, pa0, pa1, pa2, pa3); SBAR(); \
    pv2(o, vb0 + (((t) - 1) & 3) * VSLOT, pa0, pa1, pa2, pa3); partialSM<false>(C0, C1, m_reg, negm, alC); \
    RESC(alC); } while (0)
  DMA_K(2, 2); DMA_K(3, 3); DMA_V(1, 1); DMA_V(2, 2);
  qkt(pA0, pA1, lds + LDS_KR, qr, negm, r32, hi); partialSM<true>(pA0, pA1, m_reg, negm, alA);
  STEP(pB0, pB1, alB, pA0, pA1, alA, 1);
  WAIT_BAR(0);
  for (int t = 2; t < NT; t += 2) {
    if (t + 2 < NT) { DMA_K(t + 2, (t + 2) & 3); DMA_K(t + 3, (t + 3) & 3); }
    if (t + 1 < NT) DMA_V(t + 1, (t + 1) & 3); if (t + 2 < NT) DMA_V(t + 2, (t + 2) & 3);
    STEP(pA0, pA1, alA, pB0, pB1, alB, t);
    STEP(pB0, pB1, alB, pA0, pA1, alA, t + 1);
    WAIT_BAR(0);
  }
  finishSM(pB0, pB1, alB, l_reg, pa0, pa1, pa2, pa3); SBAR();
  pv2(o, vb0 + ((NT - 1) & 3) * VSLOT, pa0, pa1, pa2, pa3);
  if (hi == 0) li_l[r32] = l_reg; asm volatile("s_waitcnt lgkmcnt(0)" ::: "memory");
  float rli[16];
#pragma unroll
  for (int r = 0; r < 16; ++r) rli[r] = __builtin_amdgcn_rcpf(li_l[crow(r, hi)]);
  bf16_t* Ow = Ob + (long)(wid * QBLK) * LDO;
#pragma unroll
  for (int r = 0; r < 16; ++r) { const int orow = crow(r, hi);
#pragma unroll
    for (int d0 = 0; d0 < 2; ++d0) Ow[(long)orow * LDO + d0 * 32 + r32] = (bf16_t)(cvt_pk(o[d0][r] * rli[r], 0.f) & 0xffffu); }
  asm volatile("s_waitcnt lgkmcnt(0)\n\ts_barrier" ::: "memory");
#undef DMA_K
#undef DMA_V
#undef RESC
#undef STEP
}
#undef SBAR
}

__device__ __forceinline__ void attention_phase(const Args& a, unsigned char* lds, const int wv, int l) {
    unsigned char* ws = a.ws; const float* gq = a.in[8] + l * DQK; const float2* rt = (const float2*)(ws + WS_ROPE);
    const bf16_t* Qb = (const bf16_t*)(ws + WS_QB); const bf16_t* Kb = (const bf16_t*)(ws + WS_KB); const bf16_t* KV = (const bf16_t*)(ws + WS_KVRAW); bf16_t* FA = (bf16_t*)(ws + WS_FA);
    const int G = lgdim();
    for (int u = lbid(); u < 512; u += G) { const int h = u & 7, qb = u >> 3; const size_t t0 = TP;
        att::attn_unit(Qb + (t0 + (size_t)qb * 256) * 768 + h * 96, Kb + t0 * 768 + h * 96, KV + t0 * 1024 + h * 128 + 64, FA + (t0 + (size_t)qb * 256) * 1024 + 512 + h * 64, 16384, (char*)lds, wv, gq, rt, qb * 256); }
    for (int u = lbid() * 8; u < 2048; u += G * 8)
        for (int qb = 0; qb < 8; ++qb) { const int bh = u >> 3, b = bh >> 3, h = bh & 7; const size_t t0 = (size_t)b * 2048;
            att::attn_unit(Qb + (t0 + (size_t)qb * 256) * 768 + h * 96, Kb + t0 * 768 + h * 96, KV + t0 * 1024 + h * 128 + 64, FA + (t0 + (size_t)qb * 256) * 1024 + 512 + h * 64, 2048, (char*)lds, wv, gq, rt, qb * 256); }
    __syncthreads();
}


typedef const __attribute__((address_space(4))) Args* KArgs;
extern __shared__ __attribute__((aligned(16))) unsigned char lds_dyn[];

#define XB_TMO      128
#define XB_XCNT(j)  (256  + 64 * (j))
#define XB_XSUB(j)  (1280 + 64 * (j))
#define XB_XGEN(j)  (2304 + 64 * (j))
#define XB_TOP      3328
#define XB_TOPGEN   3392
#define XCD_BAR_WORDS 3456
#define XB_SPIN_CAP (1u << 18)
__device__ __forceinline__ unsigned xb_ld(unsigned* p)              { return __hip_atomic_load(p, __ATOMIC_RELAXED, __HIP_MEMORY_SCOPE_AGENT); }
__device__ __forceinline__ unsigned xb_add(unsigned* p, unsigned v) { return __hip_atomic_fetch_add(p, v, __ATOMIC_RELAXED, __HIP_MEMORY_SCOPE_AGENT); }
__device__ __forceinline__ unsigned xb_xcc_id() { return (unsigned)__builtin_amdgcn_s_getreg((3 << 11) | 20) & 0xFu; }
#define XB_SPIN(cond, bar) do { unsigned _sp = 0; while (cond) { __builtin_amdgcn_s_sleep(1); \
    if ((++_sp & 255u) == 0u) { if (xb_ld(&(bar)[XB_TMO])) break; if (_sp > XB_SPIN_CAP) { atomicAdd(&(bar)[XB_TMO], 1u); break; } } } } while (0)
__device__ __forceinline__ void xcd_barrier_complete(unsigned* bar, unsigned x, unsigned& nloc, unsigned& nx) {
    const unsigned G = gridDim.x * gridDim.y * gridDim.z;
    unsigned sum, cnt, mine, sp = 0u;
    for (;;) {
        sum = 0u; cnt = 0u; mine = 0u;
#pragma unroll
        for (unsigned j = 0; j < 16; ++j) { const unsigned c = xb_ld(&bar[XB_XCNT(j)]); sum += c; cnt += (c > 0u) ? 1u : 0u; mine = (j == x) ? c : mine; }
        if (sum == G) break;
        __builtin_amdgcn_s_sleep(1);
        if ((++sp & 255u) == 0u) { if (xb_ld(&bar[XB_TMO])) break; if (sp > XB_SPIN_CAP) { atomicAdd(&bar[XB_TMO], 1u); break; } }
    }
    nloc = mine > 0u ? mine : 1u; nx = cnt > 0u ? cnt : 1u;
}
__device__ __forceinline__ void grid_barrier(unsigned* bar, volatile LAS unsigned* st, const int wv) {
    asm volatile("s_waitcnt vmcnt(0)" ::: "memory");
    __syncthreads();
    if (ltid(wv) == 0) {
        const unsigned x = xb_xcc_id();
        __builtin_amdgcn_s_waitcnt(0);
        unsigned nloc = st[0], nx = st[1];
        if (nloc == 0u) { xcd_barrier_complete(bar, x, nloc, nx); st[0] = nloc; st[1] = nx; }
        const unsigned old = xb_add(&bar[XB_XSUB(x)], 1u);
        const unsigned gen = old / nloc;
        if (old + 1u == (gen + 1u) * nloc) {
            __builtin_amdgcn_fence(__ATOMIC_RELEASE, "agent");
            asm volatile("s_waitcnt vmcnt(0)" ::: "memory");
            const unsigned og = xb_add(&bar[XB_TOP], 1u);
            const unsigned tg = og / nx;
            if (og + 1u == (tg + 1u) * nx) xb_add(&bar[XB_TOPGEN], 1u);
            else XB_SPIN(xb_ld(&bar[XB_TOPGEN]) == tg, bar);
            __builtin_amdgcn_fence(__ATOMIC_ACQUIRE, "agent");
            xb_add(&bar[XB_XGEN(x)], 1u);
            asm volatile("s_waitcnt vmcnt(0)" ::: "memory");
        } else {
            XB_SPIN(xb_ld(&bar[XB_XGEN(x)]) == gen, bar);
            __builtin_amdgcn_fence(__ATOMIC_ACQUIRE, "agent");
            asm volatile("s_waitcnt vmcnt(0)" ::: "memory");
        }
    }
    __syncthreads();
}

constexpr int LDS_BYTES = 131072 + 64;
constexpr int N_PHASES = 17;
#ifndef PH_MASK
#define PH_MASK 0xfff
#endif
#define EN(k) (((PH_MASK) >> (k)) & 1)
#ifndef PROBE_PH
#define PROBE_PH -1
#endif
#ifndef PROBE_OFF0
#define PROBE_OFF0 230
#endif
#ifndef PROBE_OFF1
#define PROBE_OFF1 -1
#endif
#ifndef PROBE_N1
#define PROBE_N1 0
#endif
#ifndef MK_PER_PHASE
#define MK_PER_PHASE 0
#endif
template <class Epi> __device__ __forceinline__ void run_gemm(unsigned char* lds, const bf16_t* A, int lda, const bf16_t* Bt, int ldb, int N, int K, const Epi& E, const int wv) {
    asm volatile("" : "+s"(K));
    pg8::Gemm g{A, Bt, T, N, K, lda, ldb}; pg8::StaticOrder S; S.init(T, N, lgdim(), lbid());
    pg8::gemm_phase<Epi, pg8::StaticOrder, true, true>((LAS unsigned char*)lds, g, S, E, wv);
}
__device__ __forceinline__ void do_phase(const Args& a_, const int ph, unsigned char* lds, const int wv) {
#if defined(__HIP_DEVICE_COMPILE__)
        const __attribute__((address_space(4))) Args* ap = (const __attribute__((address_space(4))) Args*)__builtin_amdgcn_kernarg_segment_ptr(); asm volatile("" : "+s"(ap));
        const Args a = *ap;
#else
        const Args a = a_;
#endif
        unsigned char* ws = a.ws;
        u64* ssq_all = (u64*)(ws + WS_SSQ);
        bf16_t* AB = (bf16_t*)(ws + WS_AB);
#if PROBE_PH >= 0
        if (ph == 100) {
            const bf16_t* b0 = (const bf16_t*)(ws + PROBE_OFF0 * MiB); const bf16_t* b1 = (const bf16_t*)(ws + PROBE_OFF1 * MiB);
            for (size_t i = (size_t)lbid() * 512 + ltid(wv); i < (size_t)T * DM; i += (size_t)lgdim() * 512) {
                float v = __uint_as_float((unsigned)b0[i] << 16); if (PROBE_OFF1 >= 0 && i < (size_t)PROBE_N1) v += __uint_as_float((unsigned)b1[i] << 16);
                a.out[i] = v; }
        } else
#endif
        if (ph == 0) { if (EN(9)) p0_prologue(a, lds, wv); }
        else {
            const int l = (ph - 1) / 8, j0 = (ph - 1) % 8, j = j0 < 4 ? j0 : j0 + 1;
            unsigned char* wl = ws + WS_W + (size_t)l * W_LAYER;
            u64* ssq_x = ssq_all + (size_t)(l * 4 + 0) * T; u64* ssq_q = ssq_all + (size_t)(l * 4 + 1) * T; u64* ssq_kv = ssq_all + (size_t)(l * 4 + 2) * T; u64* ssq_h = ssq_all + (size_t)(l * 4 + 3) * T;
            if (j == 0 && EN(0)) {
                EpiIn E{(bf16_t*)(ws + WS_VC), (bf16_t*)(ws + WS_CQ), (bf16_t*)(ws + WS_CKV), ssq_x, ssq_q, ssq_kv, (bf16_t*)a.out};
                run_gemm(lds, AB, 1024, (const bf16_t*)(wl + WO_IN1), 1024, 3584, 1024, E, wv);
            } else if (j == 1 && EN(1)) {
                { EpiRowScale<0> E{(bf16_t*)(ws + WS_QB), 768, ssq_q, 1.0f / 256.0f}; run_gemm(lds, (const bf16_t*)(ws + WS_CQ), 256, (const bf16_t*)(wl + WO_UQ), 256, 768, 256, E, wv); }
                { EpiRowScale<3> E{(bf16_t*)(ws + WS_KVRAW), 1024, ssq_kv, 1.0f / 128.0f}; run_gemm(lds, (const bf16_t*)(ws + WS_CKV), 256, (const bf16_t*)(wl + WO_UKV), 128, 1024, 128, E, wv); }
            } else if (j == 2) {
                if (EN(2)) finalize_qk(a, l, wv); if (EN(10)) fourier_stage1(a, lds, wv);
            } else if (j == 3) {
                if (EN(3)) attention_phase(a, lds, wv, l); if (EN(11)) fourier_stage2(a, lds, wv);
            } else if (j == 4 && EN(4)) {
                EpiRowScale<1> E{(bf16_t*)(ws + WS_GG), 2048, ssq_x, 1.0f / 1024.0f};
                run_gemm(lds, AB, 1024, (const bf16_t*)(wl + WO_G), 1024, 2048, 1024, E, wv);
            } else if (j == 5 && EN(5)) {
                { EpiMixK E{(bf16_t*)(ws + WS_MB), (const bf16_t*)a.out}; run_gemm(lds, (const bf16_t*)(ws + WS_FA), 1024, (const bf16_t*)(wl + WO_OF), 1024, 1024, 1024, E, wv); }
            } else if (j == 6 && EN(6)) {
                if (l == 0) { EpiResid<false, true, false> E{a.in[0], a.in[1], nullptr, AB, ssq_h}; run_gemm(lds, (const bf16_t*)(ws + WS_MB), 1024, (const bf16_t*)(wl + WO_OUT), 1024, 1024, 1024, E, wv); }
                else { EpiResid<true, true, false> E{nullptr, nullptr, nullptr, AB, ssq_h}; run_gemm(lds, (const bf16_t*)(ws + WS_MB), 1024, (const bf16_t*)(wl + WO_OUT), 1024, 1024, 1024, E, wv); }
            } else if (j == 7 && EN(7)) {
                EpiRowScale<2> E{(bf16_t*)(ws + WS_UB), 4096, ssq_h, 1.0f / 1024.0f};
                run_gemm(lds, AB, 1024, (const bf16_t*)(wl + WO_UP), 1024, 4096, 1024, E, wv);
            } else if (j == 8 && EN(8)) {
                if (l == 0) { EpiResid<true, true, false> E{nullptr, nullptr, nullptr, AB, ssq_all + (size_t)4 * T}; run_gemm(lds, (const bf16_t*)(ws + WS_UB), 4096, (const bf16_t*)(wl + WO_DN), 4096, 1024, 4096, E, wv); }
                else { EpiResid<true, false, true> E{nullptr, nullptr, a.out, AB, nullptr}; run_gemm(lds, (const bf16_t*)(ws + WS_UB), 4096, (const bf16_t*)(wl + WO_DN), 4096, 1024, 4096, E, wv); }
            }
        }
}
__global__ void __launch_bounds__(512, 2) mega_fwd(Args a_) {
    unsigned char* lds = lds_dyn;
    cg::grid_group grid = cg::this_grid();
    const int ph_lo = a_.ph_lo, ph_hi = a_.ph_hi;
    const int wv = __builtin_amdgcn_readfirstlane((int)threadIdx.x >> 6);
    unsigned* bar = (unsigned*)(a_.ws + WS_BAR);
    volatile LAS unsigned* bst = (volatile LAS unsigned*)((LAS unsigned char*)lds + 131072);
    if (threadIdx.x == 0) { bst[0] = 0u; bst[1] = 0u; (void)xb_add(&bar[XB_XCNT(xb_xcc_id())], 1u); }
    __syncthreads();
    if (ph_hi < 0) grid.sync();
#define STEP(k) if (ph_lo <= (k) && (k) < ph_hi) { do_phase(a_, (k), lds, wv); if ((k) + 1 < ph_hi) grid_barrier(bar, bst, wv); }
    STEP(0) STEP(1) STEP(2) STEP(3) STEP(4) STEP(5) STEP(6) STEP(7) STEP(8) STEP(9) STEP(10) STEP(11) STEP(12) STEP(13) STEP(14) STEP(15) STEP(16)
#if PROBE_PH >= 0
    STEP(100)
#endif
#undef STEP
}

extern "C" void kernel_launch(void* const* d_in, const int* in_sizes, int n_in, void* d_out, int out_size, void* d_ws, size_t ws_size, hipStream_t stream) {
    static int grid = 0;
    if (grid == 0) {
        if (n_in != 16 || out_size != T * DM || ws_size < WS_END) { fprintf(stderr, "kernel_launch: unexpected shapes (n_in %d out %d ws %zu, need ws >= %zu)\n", n_in, out_size, ws_size, (size_t)WS_END); grid = -1; return; }
        int dev = 0, cus = 0, per_cu = 0;
        if (hipGetDevice(&dev) != hipSuccess || hipDeviceGetAttribute(&cus, hipDeviceAttributeMultiprocessorCount, dev) != hipSuccess) { fprintf(stderr, "kernel_launch: device query failed\n"); grid = -1; return; }
        if (hipFuncSetAttribute((const void*)mega_fwd, hipFuncAttributeMaxDynamicSharedMemorySize, LDS_BYTES) != hipSuccess) { fprintf(stderr, "kernel_launch: hipFuncSetAttribute failed\n"); grid = -1; return; }
        if (hipOccupancyMaxActiveBlocksPerMultiprocessor(&per_cu, (const void*)mega_fwd, 512, LDS_BYTES) != hipSuccess || per_cu < 1) { fprintf(stderr, "kernel_launch: occupancy query says %d\n", per_cu); per_cu = 1; }
        (void)hipGetLastError();
        grid = cus;
        if (grid % 8 != 0 || grid <= 0) { fprintf(stderr, "kernel_launch: unexpected CU count %d\n", cus); grid = -1; return; }
    }
    if (grid < 0) return;
    if (hipMemsetAsync((char*)d_ws + WS_BAR, 0, 16384, stream) != hipSuccess) { fprintf(stderr, "kernel_launch: memset failed\n"); return; }
    Args a{};
    for (int i = 0; i < 16; ++i) a.in[i] = (const float*)d_in[i];
    a.out = (float*)d_out; a.ws = (unsigned char*)d_ws;
#if MK_PER_PHASE
    for (int ph = 0; ph < N_PHASES; ++ph) { if (PROBE_PH >= 0 && ph > PROBE_PH) break; a.ph_lo = ph; a.ph_hi = ph + 1; hipLaunchKernelGGL(mega_fwd, dim3(grid), dim3(512), LDS_BYTES, stream, a); }
    if (PROBE_PH >= 0) { a.ph_lo = 100; a.ph_hi = 101; hipLaunchKernelGGL(mega_fwd, dim3(grid), dim3(512), LDS_BYTES, stream, a); }
#else
    a.ph_lo = 0; a.ph_hi = N_PHASES;
    void* args[] = {&a};
    hipError_t e = hipLaunchCooperativeKernel((const void*)mega_fwd, dim3(grid), dim3(512), args, LDS_BYTES, stream);
    if (e != hipSuccess) fprintf(stderr, "cooperative launch failed: %s (grid %d)\n", hipGetErrorString(e), grid);
#endif
}
```

```cpp
#include <hip/hip_runtime.h>
#include <hip/hip_cooperative_groups.h>
#include <cstdio>
#include <cstdint>
namespace cg = cooperative_groups;
__device__ __forceinline__ int lbid() { int b = blockIdx.x; asm volatile("" : "+s"(b)); return b; }
__device__ __forceinline__ int lgdim() { int g = gridDim.x; asm volatile("" : "+s"(g)); return g; }
__device__ __forceinline__ int ltid(int wv) { int t = (wv << 6) | (int)__builtin_amdgcn_mbcnt_hi(~0u, __builtin_amdgcn_mbcnt_lo(~0u, 0u)); asm volatile("" : "+v"(t)); return t; }
namespace pg8 {
#define PG8_LAS __attribute__((address_space(3)))
typedef unsigned short bf16_t;
typedef short bf16x8 __attribute__((ext_vector_type(8)));
typedef float f32x4 __attribute__((ext_vector_type(4)));
typedef unsigned u32x4 __attribute__((ext_vector_type(4)));
constexpr int BM = 256, BK = 64, HALF = 128, HTB = HALF * BK * 2  , STAGE_BYTES = 8 * HTB, NXCD = 8, WGM = 8;

__host__ __device__ __forceinline__ int lds_byte(int r, int c) { const int st = (r >> 4) * 2 + (c >> 5), rr = r & 15, cc = c & 31, ob = rr * 64 + cc * 2; return st * 1024 + (ob ^ (((ob >> 9) & 1) << 5)); }
__host__ __device__ __forceinline__ void stage_rc(int b, int& R, int& C) { const int st = b / 1024, sb = b % 1024, swz = sb ^ (((sb >> 9) & 1) << 5); R = (st >> 1) * 16 + swz / 64; C = (st & 1) * 32 + (swz % 64) / 2; }
__host__ __device__ __forceinline__ int perm32(int rho) { const int n = rho >> 4, i = rho & 15; return 8 * (i >> 2) + 4 * n + (i & 3); }

struct Unit { int pm, pn; };
struct Gemm { const bf16_t* A; const bf16_t* Bt; int M, N, K, lda, ldb, ablk; };

struct StaticOrder {
    int nM, nN, nwg, G, c;
    __host__ __device__ void init(int M, int N, int G_, int c_) { nM = M / BM; nN = N / BM; nwg = nM * nN; G = G_; c = c_; }
    __host__ __device__ bool next(int i, Unit& u) const {
        const long L = (long)i * G + c; if (L >= nwg) return false;
        int wgid = (int)L; { const int q = nwg / NXCD, r = nwg % NXCD, xcd = wgid % NXCD, off = wgid / NXCD; wgid = (xcd < r ? xcd * (q + 1) : r * (q + 1) + (xcd - r) * q) + off; }
        const int nig = WGM * nN, gid = wgid / nig, fm = gid * WGM, gsz = (nM - fm) < WGM ? (nM - fm) : WGM;
        u.pm = fm + ((wgid % nig) % gsz); u.pn = (wgid % nig) / gsz; return true;
    }
    __device__ __forceinline__ void a_ready(const Unit&) const {}
    __device__ __forceinline__ void done(const Unit&) const {}
};


template <class Epi, class Sched, bool ALIGN_EPI = false, bool SP2 = false>
__device__ __forceinline__ void gemm_phase(PG8_LAS unsigned char* lds, const Gemm g, const Sched& S, const Epi& E, const int wv) {
    const int tid = ltid(wv), wid = __builtin_amdgcn_readfirstlane(tid >> 6), lane = tid & 63, wr = wid >> 2, wc = wid & 3, fr = lane & 15, fq = lane >> 4;
    const int K = g.K, nt = K / BK;
    unsigned voffA[2], voffB[2];
#pragma unroll
    for (int i = 0; i < 2; ++i) { int R, C; stage_rc(tid * 16 + i * 8192, R, C); const int Rb = Epi::PERM ? ((R & ~31) + perm32(R & 31)) : R;
        voffA[i] = (unsigned)(R * (g.ablk ? BK : g.lda) + C) * 2u; voffB[i] = (unsigned)(Rb * g.ldb + C) * 2u; }
    const size_t kstepB = (size_t)(BK * 2), kstepA = g.ablk ? (size_t)(BM * BK * 2) : kstepB;
    const size_t hstepA = (size_t)HALF * (g.ablk ? BK : g.lda) * 2, hstepB = (size_t)HALF * g.ldb * 2;
    const size_t tstepA = g.ablk ? (size_t)(K / BK) * (BM * BK * 2) : 2 * hstepA, tstepB = 2 * hstepB;
    const unsigned ldsw = (unsigned)wid * 1024u;
    const int aoff = lds_byte(wr * 64 + fr, fq * 8), boff = lds_byte(wc * 32 + fr, fq * 8);
#define PG8_SA(b, h) (((b) * 2 + (h)) * HTB)
#define PG8_SB(b, h) ((4 + (b) * 2 + (h)) * HTB)
#define PG8_STAGE(bufoff, gbase, voff) do { _Pragma("unroll") for (int _i = 0; _i < 2; ++_i) \
        __builtin_amdgcn_global_load_lds((const unsigned*)((const char*)(gbase) + (voff)[_i]), (PG8_LAS unsigned*)(lds + (bufoff) + ldsw + _i * 8192), 16, 0, 0); } while (0)
#define PG8_LDA(dst, b, h) do { _Pragma("unroll") for (int m = 0; m < 4; ++m) _Pragma("unroll") for (int k = 0; k < 2; ++k) dst[m][k] = *(const PG8_LAS bf16x8*)(lds + PG8_SA(b, h) + aoff + m * 2048 + k * 1024); } while (0)
#define PG8_LDB(dst, b, h) do { _Pragma("unroll") for (int n = 0; n < 2; ++n) _Pragma("unroll") for (int k = 0; k < 2; ++k) dst[n][k] = *(const PG8_LAS bf16x8*)(lds + PG8_SB(b, h) + boff + n * 2048 + k * 1024); } while (0)
#define PG8_MMA(ai, bj, At, Bt) do { __builtin_amdgcn_s_setprio(1); _Pragma("unroll") for (int m = 0; m < 4; ++m) _Pragma("unroll") for (int n = 0; n < 2; ++n) _Pragma("unroll") for (int k = 0; k < 2; ++k) \
        acc[ai][bj][m][n] = __builtin_amdgcn_mfma_f32_16x16x32_bf16(Bt[n][k], At[m][k], acc[ai][bj][m][n], 0, 0, 0); __builtin_amdgcn_s_setprio(0); } while (0)
#define PG8_WAIT_V(n) asm volatile("s_waitcnt vmcnt(" #n ")" ::: "memory")
#define PG8_WAIT_L(n) asm volatile("s_waitcnt lgkmcnt(" #n ")" ::: "memory")
#define PG8_BAR __builtin_amdgcn_s_barrier()
#define PG8_SCHED __builtin_amdgcn_sched_barrier(0)
    Unit cur, nxt; int ui = 0;
    if (!S.next(0, cur)) return;
    f32x4 acc[2][2][4][2];
#pragma unroll
    for (int a = 0; a < 2; ++a)
#pragma unroll
        for (int b = 0; b < 2; ++b)
#pragma unroll
            for (int m = 0; m < 4; ++m)
#pragma unroll
                for (int n = 0; n < 2; ++n) acc[a][b][m][n] = (f32x4){0.f, 0.f, 0.f, 0.f};
    bf16x8 At[4][2], B0[2][2], B1[2][2];
    const char* cA = (const char*)g.A + (size_t)cur.pm * tstepA; const char* cB = (const char*)g.Bt + (size_t)cur.pn * tstepB;
    S.a_ready(cur);
    if constexpr (SP2) {
        PG8_STAGE(PG8_SB(0, 0), cB, voffB); PG8_STAGE(PG8_SB(0, 1), cB + hstepB, voffB); PG8_STAGE(PG8_SA(0, 0), cA, voffA); PG8_STAGE(PG8_SA(0, 1), cA + hstepA, voffA);
        if (wr == 1) PG8_BAR;
        PG8_WAIT_V(2); PG8_BAR;
        PG8_STAGE(PG8_SB(1, 0), cB + kstepB, voffB); PG8_STAGE(PG8_SA(1, 0), cA + kstepA, voffA); PG8_STAGE(PG8_SB(1, 1), cB + hstepB + kstepB, voffB);
        PG8_WAIT_V(6); PG8_BAR;
    } else {
        PG8_STAGE(PG8_SB(0, 0), cB, voffB); PG8_STAGE(PG8_SA(0, 0), cA, voffA); PG8_STAGE(PG8_SB(0, 1), cB + hstepB, voffB); PG8_STAGE(PG8_SA(0, 1), cA + hstepA, voffA);
        if (wr == 1) PG8_BAR;
        PG8_WAIT_V(4); PG8_BAR;
        PG8_STAGE(PG8_SB(1, 0), cB + kstepB, voffB); PG8_STAGE(PG8_SA(1, 0), cA + kstepA, voffA); PG8_STAGE(PG8_SB(1, 1), cB + hstepB + kstepB, voffB);
        PG8_WAIT_V(6); PG8_BAR;
    }
    for (;;) {
        const bool has_next = S.next(ui + 1, nxt);
        const char* nA = has_next ? (const char*)g.A + (size_t)nxt.pm * tstepA : cA; const char* nB = has_next ? (const char*)g.Bt + (size_t)nxt.pn * tstepB : cB;
        for (int t = 0; t < nt; t += 2) {
            const bool last = (t == nt - 2);
            const char* a1 = cA + (size_t)(t + 1) * kstepA;
            const char* a2 = last ? nA : cA + (size_t)(t + 2) * kstepA; const char* b2 = last ? nB : cB + (size_t)(t + 2) * kstepB;
            const char* a3 = a2 + kstepA; const char* b3 = b2 + kstepB;
            if (last && has_next) S.a_ready(nxt);
            if constexpr (SP2) {
            PG8_LDB(B0, 0, 0); PG8_LDB(B1, 0, 1); PG8_SCHED; PG8_LDA(At, 0, 0); PG8_STAGE(PG8_SA(1, 1), a1 + hstepA, voffA);
            PG8_WAIT_V(8); PG8_WAIT_L(0); PG8_BAR; PG8_MMA(0, 0, At, B0); PG8_MMA(0, 1, At, B1); PG8_BAR; PG8_SCHED;
            PG8_LDA(At, 0, 1); PG8_STAGE(PG8_SB(0, 0), b2, voffB); PG8_STAGE(PG8_SB(0, 1), b2 + hstepB, voffB); PG8_STAGE(PG8_SA(0, 0), a2, voffA);
            PG8_WAIT_V(8); PG8_WAIT_L(0); PG8_BAR; PG8_MMA(1, 0, At, B0); PG8_MMA(1, 1, At, B1); PG8_BAR; PG8_SCHED;
            PG8_LDB(B0, 1, 0); PG8_LDB(B1, 1, 1); PG8_SCHED; PG8_LDA(At, 1, 0); PG8_STAGE(PG8_SA(0, 1), a2 + hstepA, voffA);
            PG8_WAIT_V(8); PG8_WAIT_L(0); PG8_BAR; PG8_MMA(0, 0, At, B0); PG8_MMA(0, 1, At, B1); PG8_BAR; PG8_SCHED;
            PG8_LDA(At, 1, 1); PG8_STAGE(PG8_SB(1, 0), b3, voffB); PG8_STAGE(PG8_SB(1, 1), b3 + hstepB, voffB); PG8_STAGE(PG8_SA(1, 0), a3, voffA);
            PG8_WAIT_V(8); PG8_WAIT_L(0); PG8_BAR; PG8_MMA(1, 0, At, B0); PG8_MMA(1, 1, At, B1); PG8_BAR; PG8_SCHED;
            } else {
            PG8_LDB(B0, 0, 0); PG8_SCHED; PG8_LDA(At, 0, 0); PG8_STAGE(PG8_SA(1, 1), a1 + hstepA, voffA);
            PG8_WAIT_L(8); PG8_BAR; PG8_WAIT_L(0); PG8_MMA(0, 0, At, B0); PG8_BAR; PG8_SCHED;
            PG8_LDB(B1, 0, 1); PG8_STAGE(PG8_SB(0, 0), b2, voffB);
            PG8_BAR; PG8_WAIT_L(0); PG8_MMA(0, 1, At, B1); PG8_BAR;
            PG8_LDA(At, 0, 1); PG8_STAGE(PG8_SA(0, 0), a2, voffA);
            PG8_BAR; PG8_WAIT_L(0); PG8_MMA(1, 0, At, B0); PG8_BAR; PG8_SCHED;
            PG8_STAGE(PG8_SB(0, 1), b2 + hstepB, voffB);
            PG8_WAIT_V(6); PG8_BAR; PG8_MMA(1, 1, At, B1); PG8_BAR;
            PG8_LDB(B0, 1, 0); PG8_SCHED; PG8_LDA(At, 1, 0); PG8_STAGE(PG8_SA(0, 1), a2 + hstepA, voffA);
            PG8_WAIT_L(8); PG8_BAR; PG8_WAIT_L(0); PG8_MMA(0, 0, At, B0); PG8_BAR; PG8_SCHED;
            PG8_LDB(B1, 1, 1); PG8_STAGE(PG8_SB(1, 0), b3, voffB);
            PG8_BAR; PG8_WAIT_L(0); PG8_MMA(0, 1, At, B1); PG8_BAR;
            PG8_LDA(At, 1, 1); PG8_STAGE(PG8_SA(1, 0), a3, voffA);
            PG8_BAR; PG8_WAIT_L(0); PG8_MMA(1, 0, At, B0); PG8_BAR; PG8_SCHED;
            PG8_STAGE(PG8_SB(1, 1), b3 + hstepB, voffB);
            PG8_WAIT_V(6); PG8_BAR; PG8_MMA(1, 1, At, B1); PG8_BAR;
            }
            if constexpr (Epi::MIDK) { if (t + 2 == (nt >> 1)) E.mid(acc, cur, wr, wc, fr, fq); }
        }
        if constexpr (ALIGN_EPI) { if (wr == 0) PG8_BAR; }
        if constexpr (!Epi::AFTER_DRAIN) { E(acc, cur, wr, wc, fr, fq); S.done(cur); }
        if (!has_next) break;
#pragma unroll
        for (int a = 0; a < 2; ++a)
#pragma unroll
            for (int b = 0; b < 2; ++b)
#pragma unroll
                for (int m = 0; m < 4; ++m)
#pragma unroll
                    for (int n = 0; n < 2; ++n) acc[a][b][m][n] = (f32x4){0.f, 0.f, 0.f, 0.f};
        cur = nxt; cA = nA; cB = nB; ++ui;
        if constexpr (ALIGN_EPI) { if (wr == 1) PG8_BAR; }
    }
    PG8_WAIT_V(0);
    if constexpr (!ALIGN_EPI) { if (wr == 0) PG8_BAR; }
    PG8_BAR;
    if constexpr (Epi::AFTER_DRAIN) { E.fused(acc, cur, wr, wc, fr, fq, lds, wid, lane); S.done(cur); }
#undef PG8_SA
#undef PG8_SB
#undef PG8_STAGE
#undef PG8_LDA
#undef PG8_LDB
#undef PG8_MMA
#undef PG8_WAIT_V
#undef PG8_WAIT_L
#undef PG8_BAR
#undef PG8_SCHED
}
}


#define LAS __attribute__((address_space(3)))
using pg8::bf16_t; using pg8::bf16x8; using pg8::f32x4; using pg8::u32x4; using pg8::Unit;
typedef float f32x16 __attribute__((ext_vector_type(16)));
typedef unsigned u32x2 __attribute__((ext_vector_type(2)));
typedef short s16x4 __attribute__((ext_vector_type(4)));
constexpr int DM = 1024, TP = 65536, TS = 16384, T = TP + TS;
constexpr int NH = 8, DQK = 96, DFF = 4096, INW = 2976;
constexpr float EPS = 1e-6f;
constexpr size_t MiB = (size_t)1 << 20;
constexpr size_t WS_SSQ = 0;
constexpr size_t WS_BAR = 5 * MiB + 832 * 1024;
constexpr size_t WS_ROPE = 950 * MiB;
constexpr size_t WS_M1A = 5 * MiB, WS_M1B = 5 * MiB + 65536, WS_M2A = 5 * MiB + 262144, WS_M2B = 6 * MiB;
constexpr size_t WS_W = 14 * MiB, W_LAYER = 28 * MiB;
constexpr size_t WO_IN1 = 0, WO_G = 3 * MiB, WO_UQ = 7 * MiB, WO_UKV = 7 * MiB + 393216, WO_OF = 8 * MiB, WO_OA = 9 * MiB, WO_OUT = 10 * MiB, WO_UP = 12 * MiB, WO_DN = 20 * MiB;
constexpr size_t WS_AB = 70 * MiB;
constexpr size_t WS_BIG = 230 * MiB;
constexpr size_t WS_VC = WS_BIG, WS_KVRAW = WS_BIG + 160 * MiB, WS_QB = WS_BIG + 320 * MiB, WS_KB = WS_BIG + 440 * MiB;
constexpr size_t WS_CQ = WS_BIG + 560 * MiB, WS_CKV = WS_BIG + 600 * MiB, WS_FA = WS_BIG + 560 * MiB;
constexpr size_t WS_GG = WS_BIG, WS_MB = WS_BIG + 320 * MiB, WS_UB = WS_BIG;
constexpr size_t WS_END = 952 * MiB;

typedef float f32x2_t __attribute__((ext_vector_type(2))); typedef __bf16 bf16x2_t __attribute__((ext_vector_type(2)));
__device__ __forceinline__ unsigned cvt_pk(float lo, float hi) { f32x2_t v = {lo, hi}; bf16x2_t b = __builtin_convertvector(v, bf16x2_t); return __builtin_bit_cast(unsigned, b); }
__device__ __forceinline__ float bf_lo(unsigned w) { return __uint_as_float(w << 16); }
__device__ __forceinline__ float bf_hi(unsigned w) { return __uint_as_float(w & 0xffff0000u); }
__device__ __forceinline__ u32x4 pack8(f32x4 a, f32x4 b) { u32x4 w; w.x = cvt_pk(a[0], a[1]); w.y = cvt_pk(a[2], a[3]); w.z = cvt_pk(b[0], b[1]); w.w = cvt_pk(b[2], b[3]); return w; }
__device__ __forceinline__ float sumsq8(f32x4 a, f32x4 b) { return (a[0] * a[0] + a[1] * a[1]) + (a[2] * a[2] + a[3] * a[3]) + (b[0] * b[0] + b[1] * b[1]) + (b[2] * b[2] + b[3] * b[3]); }
__device__ __forceinline__ void unpack8(u32x4 w, f32x4& a, f32x4& b) { a[0] = bf_lo(w.x); a[1] = bf_hi(w.x); a[2] = bf_lo(w.y); a[3] = bf_hi(w.y); b[0] = bf_lo(w.z); b[1] = bf_hi(w.z); b[2] = bf_lo(w.w); b[3] = bf_hi(w.w); }
typedef unsigned long long u64;
__device__ __forceinline__ float rs_of(u64 ssq, float inv_n) { return 1.0f / sqrtf(__ull2float_rn(ssq) * 2.3283064365386963e-10f * inv_n + EPS); }
__device__ __forceinline__ void ssq_add(u64* p, float s) { atomicAdd(p, __float2ull_rn(s * 4294967296.0f)); }

struct EpiIn {
    static constexpr bool PERM = true, AFTER_DRAIN = false, MIDK = false;
    bf16_t* Vc; bf16_t* CQ; bf16_t* CKV; const u64* ssq_x; u64* ssq_q; u64* ssq_kv; bf16_t* GG;
    __device__ __forceinline__ void operator()(const f32x4 (&acc)[2][2][4][2], const Unit& u, int wr, int wc, int fr, int fq) const {
        const int row0 = u.pm * 256 + wr * 64 + fr;
        if (u.pn >= 6) {
            const int col0 = (u.pn - 6) * 256 + wc * 32 + 8 * fq;
#pragma unroll
            for (int ai = 0; ai < 2; ++ai)
#pragma unroll
                for (int m = 0; m < 4; ++m) {
                    const int row = row0 + ai * 128 + m * 16;
                    const float rs = rs_of(ssq_x[row], 1.0f / 1024.0f);
                    bf16_t* rp = GG + (size_t)row * 2048 + col0;
#pragma unroll
                    for (int bj = 0; bj < 2; ++bj) { f32x4 v0 = acc[ai][bj][m][0] * rs, v1 = acc[ai][bj][m][1] * rs;
#pragma unroll
                        for (int e = 0; e < 4; ++e) { v0[e] = __builtin_amdgcn_rcpf(1.0f + __expf(-v0[e])); v1[e] = __builtin_amdgcn_rcpf(1.0f + __expf(-v1[e])); }
                        *(u32x4*)(rp + bj * 128) = pack8(v0, v1); }
                }
            return;
        }
        bf16_t* base; int ldc, colt; u64* ssq;
        if (u.pn < 4) { base = Vc; ldc = 1024; colt = u.pn * 256; ssq = nullptr; }
        else if (u.pn == 4) { base = CQ; ldc = 256; colt = 0; ssq = ssq_q; }
        else { base = CKV; ldc = 256; colt = 0; ssq = ssq_kv; }
        const bool only0 = (u.pn == 5);
        const int col0 = colt + wc * 32 + 8 * fq;
#pragma unroll
        for (int ai = 0; ai < 2; ++ai)
#pragma unroll
            for (int m = 0; m < 4; ++m) {
                const int row = row0 + ai * 128 + m * 16;
                const float rs = rs_of(ssq_x[row], 1.0f / 1024.0f);
                const f32x4 a0 = acc[ai][0][m][0] * rs, a1 = acc[ai][0][m][1] * rs, b0 = acc[ai][1][m][0] * rs, b1 = acc[ai][1][m][1] * rs;
                bf16_t* rp = base + (size_t)row * ldc + col0;
                *(u32x4*)(rp) = pack8(a0, a1); *(u32x4*)(rp + 128) = pack8(b0, b1);
                if (ssq) { float s = sumsq8(a0, a1); if (!only0) s += sumsq8(b0, b1);
                    s += __shfl_xor(s, 16); s += __shfl_xor(s, 32); if (fq == 0) ssq_add(ssq + row, s); }
            }
    }
};
template <int ACT, bool BLK = false> struct EpiRowScale {
    static constexpr bool PERM = true, AFTER_DRAIN = false, MIDK = false;
    bf16_t* O; int ldc; const u64* ssq; float inv_n;
    static __device__ __forceinline__ float act(float v) {
        if (ACT == 1) return __builtin_amdgcn_rcpf(1.0f + __expf(-v));
        if (ACT == 2) { const float r = fmaxf(v, 0.f); return r * r; }
        return v; }
    __device__ __forceinline__ void operator()(const f32x4 (&acc)[2][2][4][2], const Unit& u, int wr, int wc, int fr, int fq) const {
        const int row0 = u.pm * 256 + wr * 64 + fr, col0 = u.pn * 256 + wc * 32 + 8 * fq;
#pragma unroll
        for (int ai = 0; ai < 2; ++ai)
#pragma unroll
            for (int m = 0; m < 4; ++m) {
                const int row = row0 + ai * 128 + m * 16;
                const float rs = rs_of(ssq[row], inv_n);
                bf16_t* rp = BLK ? O + (((size_t)(row >> 8) * (ldc >> 6) + (col0 >> 6)) * 256 + (row & 255)) * 64 + (col0 & 63) : O + (size_t)row * ldc + col0;
#pragma unroll
                for (int bj = 0; bj < 2; ++bj) { f32x4 v0 = acc[ai][bj][m][0] * rs, v1 = acc[ai][bj][m][1] * rs;
#pragma unroll
                    for (int e = 0; e < 4; ++e) { v0[e] = act(v0[e]); v1[e] = act(v1[e]); }
                    *(u32x4*)(rp + (BLK ? bj * 2 * 256 * 64 : bj * 128)) = pack8(v0, v1); }
            }
    }
};
struct EpiMixK {
    static constexpr bool PERM = true, AFTER_DRAIN = false, MIDK = true;
    bf16_t* Mb; const bf16_t* GG;
    __device__ __forceinline__ void mid(f32x4 (&acc)[2][2][4][2], const Unit& u, int wr, int wc, int fr, int fq) const {
        const int row0 = u.pm * 256 + wr * 64 + fr, col0 = u.pn * 256 + wc * 32 + 8 * fq;
#pragma unroll
        for (int ai = 0; ai < 2; ++ai)
#pragma unroll
            for (int m = 0; m < 4; ++m) {
                const bf16_t* gp = GG + (size_t)(row0 + ai * 128 + m * 16) * 2048 + col0;
#pragma unroll
                for (int bj = 0; bj < 2; ++bj) { f32x4 f0, f1, a0, a1; unpack8(*(const u32x4*)(gp + bj * 128), f0, f1); unpack8(*(const u32x4*)(gp + 1024 + bj * 128), a0, a1);
#pragma unroll
                    for (int e = 0; e < 4; ++e) { acc[ai][bj][m][0][e] *= f0[e] * __builtin_amdgcn_rcpf(fmaxf(a0[e], 1e-30f)); acc[ai][bj][m][1][e] *= f1[e] * __builtin_amdgcn_rcpf(fmaxf(a1[e], 1e-30f)); } }
                asm volatile("" ::: "memory");
            }
    }
    __device__ __forceinline__ void operator()(const f32x4 (&acc)[2][2][4][2], const Unit& u, int wr, int wc, int fr, int fq) const {
        const int row0 = u.pm * 256 + wr * 64 + fr, col0 = u.pn * 256 + wc * 32 + 8 * fq;
#pragma unroll
        for (int ai = 0; ai < 2; ++ai)
#pragma unroll
            for (int m = 0; m < 4; ++m) {
                const int row = row0 + ai * 128 + m * 16;
                const bf16_t* gp = GG + (size_t)row * 2048 + 1024 + col0; bf16_t* mp = Mb + (size_t)row * 1024 + col0;
#pragma unroll
                for (int bj = 0; bj < 2; ++bj) { f32x4 a0, a1; unpack8(*(const u32x4*)(gp + bj * 128), a0, a1);
#pragma unroll
                    for (int e = 0; e < 4; ++e) { a0[e] = fmaxf(a0[e], 1e-30f); a1[e] = fmaxf(a1[e], 1e-30f); }
                    *(u32x4*)(mp + bj * 128) = pack8(acc[ai][bj][m][0] * a0, acc[ai][bj][m][1] * a1); }
                asm volatile("" ::: "memory");
            }
    }
};
template <bool RES_BF16, bool WR_AB, bool WR_F32> struct EpiResid {
    static constexpr bool PERM = true, AFTER_DRAIN = false, MIDK = false;
    const float* res0; const float* res1; float* out; bf16_t* ab; u64* ssq;
    __device__ __forceinline__ void operator()(const f32x4 (&acc)[2][2][4][2], const Unit& u, int wr, int wc, int fr, int fq) const {
        const int row0 = u.pm * 256 + wr * 64 + fr, col0 = u.pn * 256 + wc * 32 + 8 * fq;
        const float* rbase = (u.pm * 256 < TP) ? res0 : (res1 - (size_t)TP * 1024);
#pragma unroll
        for (int ai = 0; ai < 2; ++ai)
#pragma unroll
            for (int m = 0; m < 4; ++m) {
                const int row = row0 + ai * 128 + m * 16;
                const size_t off = (size_t)row * 1024 + col0;
                float s = 0.f;
#pragma unroll
                for (int bj = 0; bj < 2; ++bj) {
                    f32x4 r0, r1;
                    if (RES_BF16) unpack8(*(const u32x4*)(ab + off + bj * 128), r0, r1);
                    else { r0 = *(const f32x4*)(rbase + off + bj * 128); r1 = *(const f32x4*)(rbase + off + bj * 128 + 4); }
                    const f32x4 v0 = r0 + acc[ai][bj][m][0], v1 = r1 + acc[ai][bj][m][1];
                    if (WR_F32) { *(f32x4*)(out + off + bj * 128) = v0; *(f32x4*)(out + off + bj * 128 + 4) = v1; }
                    if (WR_AB) { *(u32x4*)(ab + off + bj * 128) = pack8(v0, v1); s += sumsq8(v0, v1); } }
                if (WR_AB) { if (ssq) { s += __shfl_xor(s, 16); s += __shfl_xor(s, 32); if (fq == 0) ssq_add(ssq + row, s); } }
                asm volatile("" ::: "memory");
            }
    }
};
struct Args { const float* in[16]; float* out; unsigned char* ws; int ph_lo, ph_hi; };
__device__ __forceinline__ float wave_sum(float v) {
#pragma unroll
    for (int o = 1; o < 64; o <<= 1) v += __shfl_xor(v, o);
    return v;
}
#define LDS_WAIT() asm volatile("s_waitcnt lgkmcnt(0)" ::: "memory")

__device__ __forceinline__ void tr_item(const float* __restrict__ W, int ldw, int col0, int K, const float* __restrict__ gain, bf16_t* __restrict__ WT, int ldt, int kofs, int row0, int nblk, LAS float* scr, int item, int lane) {
    const int kb = item / nblk, nb = item % nblk, k0 = 64 * kb, n0 = 32 * nb;
#pragma unroll 8
    for (int i = 0; i < 32; ++i) { const int kk = 2 * i + (lane >> 5); const float g = gain ? gain[k0 + kk] : 1.0f;
        scr[kk * 33 + (lane & 31)] = W[(size_t)(k0 + kk) * ldw + col0 + n0 + (lane & 31)] * g; }
    LDS_WAIT(); asm volatile("" ::: "memory");
    const int c = lane & 7;
#pragma unroll
    for (int j = 0; j < 4; ++j) { const int n = (lane >> 3) + 8 * j; const LAS float* s = scr + (8 * c) * 33 + n;
        u32x4 o; o.x = cvt_pk(s[0 * 33], s[1 * 33]); o.y = cvt_pk(s[2 * 33], s[3 * 33]); o.z = cvt_pk(s[4 * 33], s[5 * 33]); o.w = cvt_pk(s[6 * 33], s[7 * 33]);
        *(u32x4*)(WT + (size_t)(row0 + n0 + n) * ldt + kofs + k0 + 8 * c) = o; }
    LDS_WAIT(); asm volatile("" ::: "memory");
}
__device__ __forceinline__ void tr_piece(const float* W, int ldw, int col0, int ncols, int K, const float* gain, bf16_t* WT, int row0, LAS float* scr, int gw, int NGW, int lane, int ldt = 0, int kofs = 0) {
    const int nblk = ncols / 32, nitems = (K / 64) * nblk;
    for (int it = gw; it < nitems; it += NGW) tr_item(W, ldw, col0, K, gain, WT, ldt ? ldt : K, kofs, row0, nblk, scr, it, lane);
}

__device__ __forceinline__ void p0_prologue(const Args& a, unsigned char* lds_g, const int wv) {
    LAS unsigned char* lds = (LAS unsigned char*)lds_g;
    const int tid = ltid(wv), lane = tid & 63, wave = tid >> 6, G = lgdim();
    const int gw = lbid() * 8 + wave, NGW = G * 8, gt = lbid() * 512 + tid, NGT = G * 512;
    unsigned char* ws = a.ws;
    u64* ssq = (u64*)(ws + WS_SSQ);
    for (int i = gt + T; i < 8 * T; i += NGT) ssq[i] = 0ull;
    bf16_t* AB = (bf16_t*)(ws + WS_AB);
    for (int m = gw; m < T; m += NGW) {
        const float* xr = (m < TP) ? a.in[0] + (size_t)m * DM : a.in[1] + (size_t)(m - TP) * DM;
        f32x4 v[4]; float s = 0.f;
#pragma unroll
        for (int j = 0; j < 4; ++j) { v[j] = ((const f32x4*)xr)[lane + 64 * j]; s += (v[j][0] * v[j][0] + v[j][1] * v[j][1]) + (v[j][2] * v[j][2] + v[j][3] * v[j][3]); }
        s = wave_sum(s);
        u32x2* o8 = (u32x2*)(AB + (size_t)m * DM);
#pragma unroll
        for (int j = 0; j < 4; ++j) { u32x2 w; w.x = cvt_pk(v[j][0], v[j][1]); w.y = cvt_pk(v[j][2], v[j][3]); o8[lane + 64 * j] = w; }
        if (lane == 0) ssq[m] = __float2ull_rn(s * 4294967296.0f);
    }
    LAS float* scr = (LAS float*)(lds + wave * 16384);
    for (int l = 0; l < 2; ++l) {
        unsigned char* wl = ws + WS_W + (size_t)l * W_LAYER;
        const float* w_in = a.in[3] + (size_t)l * DM * INW; const float* g1 = a.in[2] + l * DM;
        tr_piece(w_in, INW, 512, 256, DM, g1, (bf16_t*)(wl + WO_IN1), 1024, scr, gw, NGW, lane);
        tr_piece(w_in, INW, 768, 160, DM, g1, (bf16_t*)(wl + WO_IN1), 1280, scr, gw, NGW, lane);
        tr_piece(w_in, INW, 928, 2048, DM, g1, (bf16_t*)(wl + WO_G), 0, scr, gw, NGW, lane);
        tr_piece(a.in[5] + (size_t)l * 256 * 768, 768, 0, 768, 256, a.in[4] + l * 256, (bf16_t*)(wl + WO_UQ), 0, scr, gw, NGW, lane);
        tr_piece(a.in[7] + (size_t)l * 128 * 1024, 1024, 0, 1024, 128, a.in[6] + l * 128, (bf16_t*)(wl + WO_UKV), 0, scr, gw, NGW, lane);
        tr_piece(a.in[10] + (size_t)l * 512 * 1024, 1024, 0, 1024, 512, nullptr, (bf16_t*)(wl + WO_OF), 0, scr, gw, NGW, lane, 1024, 0);
        tr_piece(a.in[11] + (size_t)l * 512 * 1024, 1024, 0, 1024, 512, nullptr, (bf16_t*)(wl + WO_OF), 0, scr, gw, NGW, lane, 1024, 512);
        tr_piece(a.in[12] + (size_t)l * 1024 * 1024, 1024, 0, 1024, 1024, nullptr, (bf16_t*)(wl + WO_OUT), 0, scr, gw, NGW, lane);
        tr_piece(a.in[14] + (size_t)l * 1024 * 4096, 4096, 0, 4096, 1024, a.in[13] + l * DM, (bf16_t*)(wl + WO_UP), 0, scr, gw, NGW, lane);
        tr_piece(a.in[15] + (size_t)l * 4096 * 1024, 1024, 0, 1024, 4096, nullptr, (bf16_t*)(wl + WO_DN), 0, scr, gw, NGW, lane);
        u32x4* z = (u32x4*)((bf16_t*)(wl + WO_IN1) + (size_t)1440 * DM);
        for (int i = gt; i < 96 * DM / 8; i += NGT) z[i] = (u32x4){0u, 0u, 0u, 0u};
    }
    {
        bf16_t* m1a = (bf16_t*)(ws + WS_M1A); bf16_t* m1b = (bf16_t*)(ws + WS_M1B); bf16_t* m2a = (bf16_t*)(ws + WS_M2A); bf16_t* m2b = (bf16_t*)(ws + WS_M2B);
        for (int i = gt; i < 64 * 64 + 256 * 256; i += NGT) {
            const bool big = i >= 64 * 64; const int j = big ? i - 64 * 64 : i; const int N1 = big ? 128 : 32, W2 = 2 * N1;
            const int r = j / W2, c = j % W2, pp = r / N1, k1 = r % N1, p = c / N1, n1 = c % N1;
            const float ang = 2.0f * (float)((n1 * k1) % N1) / (float)N1; const float cs = cospif(ang), sn = sinpif(ang);
            const float sc = big ? 0.0078125f : 0.02209708691207961f;
            const float v = (pp == p) ? cs : (pp == 0 ? sn : -sn);
            (big ? m1b : m1a)[j] = (bf16_t)(cvt_pk(v * sc, 0.f) & 0xffffu);
        }
        for (int i = gt; i < 32 * 64 * 128 + 128 * 128 * 256; i += NGT) {
            const bool big = i >= 32 * 64 * 128; const int j = big ? i - 32 * 64 * 128 : i;
            const int N1 = big ? 128 : 32, N2 = big ? 128 : 64, S = N1 * N2, W2 = 2 * N2;
            const int c = j % W2, k2 = (j / W2) % N2, k1 = j / (W2 * N2), p = c / N2, n2 = c % N2;
            const int mm = (n2 * (k1 + N1 * k2)) % S; const float ang = 2.0f * (float)mm / (float)S;
            const float v = p ? sinpif(ang) : cospif(ang);
            (big ? m2b : m2a)[j] = (bf16_t)(cvt_pk(v, 0.f) & 0xffffu);
        }
        float2* rt = (float2*)(ws + WS_ROPE);
        for (int i = gt; i < 16384 * 16; i += NGT) { const int pos = i >> 4, f = i & 15;
            const float inv = powf(10000.0f, -(float)(2 * f) / 32.0f); const float ang = (float)pos * inv; float s, c; sincosf(ang, &s, &c); rt[i] = make_float2(c, s); }
    }
    __syncthreads();
    {
        LAS float* cs = (LAS float*)lds; LAS float* sn = cs + 128; LAS float* wl_s = sn + 128;
        if (tid < 128) { cs[tid] = cospif(2.0f * (float)tid / 128.0f); sn[tid] = sinpif(2.0f * (float)tid / 128.0f); }
        for (int it = lbid(); it < 2 * 128 * 4; it += G) {
            const int l = it >> 9, db = (it >> 2) & 127, g = it & 3, d0 = db * 8;
            const float* w_in = a.in[3] + (size_t)l * DM * INW; const float* g1 = a.in[2] + l * DM;
            __syncthreads();
            for (int i = tid; i < 1024; i += 512) wl_s[i] = w_in[(size_t)(d0 + (i >> 7)) * INW + g * 128 + (i & 127)];
            __syncthreads();
            const int j = tid & 127, p = (tid >> 7) & 1, dh = tid >> 8;
            float acc0 = 0.f, acc1 = 0.f, acc2 = 0.f, acc3 = 0.f;
            for (int c = 0; c < 128; ++c) { const int idx = (c * j) & 127; const float w = p ? -sn[idx] : cs[idx];
                acc0 += wl_s[(dh * 4 + 0) * 128 + c] * w; acc1 += wl_s[(dh * 4 + 1) * 128 + c] * w; acc2 += wl_s[(dh * 4 + 2) * 128 + c] * w; acc3 += wl_s[(dh * 4 + 3) * 128 + c] * w; }
            const float sc = 0.08838834764831845f; const int dd = d0 + dh * 4;
            u32x2 o; o.x = cvt_pk(acc0 * sc * g1[dd], acc1 * sc * g1[dd + 1]); o.y = cvt_pk(acc2 * sc * g1[dd + 2], acc3 * sc * g1[dd + 3]);
            bf16_t* dst = (bf16_t*)(ws + WS_W + (size_t)l * W_LAYER + WO_IN1) + (size_t)(p * 512 + g * 128 + j) * DM + dd;
            *(u32x2*)dst = o;
        }
        __syncthreads();
    }
}

template <bool WHICH> __device__ __forceinline__ const bf16_t* fin_src(const bf16_t* Qb, const bf16_t* KV, const bf16_t* CKV, int token, int h, int pc) {
    return !WHICH ? Qb + (size_t)token * 768 + h * 96 + pc * 32 : (pc < 2 ? KV + (size_t)token * 1024 + h * 128 + pc * 32 : CKV + (size_t)token * 256 + 128);
}
__device__ __forceinline__ void fin_math(const u32x4 (&w)[4], const float (&g)[32], const float2* __restrict__ rt, int token, int part, u32x4 (&o)[4]) {
    float v[32];
#pragma unroll
    for (int j = 0; j < 4; ++j) { v[8*j] = bf_lo(w[j].x); v[8*j+1] = bf_hi(w[j].x); v[8*j+2] = bf_lo(w[j].y); v[8*j+3] = bf_hi(w[j].y); v[8*j+4] = bf_lo(w[j].z); v[8*j+5] = bf_hi(w[j].z); v[8*j+6] = bf_lo(w[j].w); v[8*j+7] = bf_hi(w[j].w); }
    float ss = 0.f;
#pragma unroll
    for (int d = 0; d < 32; ++d) ss += v[d] * v[d];
    if (part == 3) ss = 0.f;
    ss += __shfl_xor(ss, 1); ss += __shfl_xor(ss, 2);
    const float r = 1.0f / sqrtf(ss * (1.0f / 96.0f) + EPS);
#pragma unroll
    for (int d = 0; d < 32; ++d) v[d] = v[d] * r * g[d];
    if (part == 2) { const int pos = token < TP ? (token & 2047) : token - TP;
#pragma unroll
        for (int f = 0; f < 16; ++f) { const float2 cs = rt[pos * 16 + f]; const float x1 = v[f], x2 = v[16 + f]; v[f] = x1 * cs.x - x2 * cs.y; v[16 + f] = x2 * cs.x + x1 * cs.y; } }
#pragma unroll
    for (int j = 0; j < 4; ++j) { o[j].x = cvt_pk(v[8*j], v[8*j+1]); o[j].y = cvt_pk(v[8*j+2], v[8*j+3]); o[j].z = cvt_pk(v[8*j+4], v[8*j+5]); o[j].w = cvt_pk(v[8*j+6], v[8*j+7]); }
}
template <bool WHICH> __device__ __forceinline__ void finalize_pass(const Args& a, int l, const int wv) {
    unsigned char* ws = a.ws;
    bf16_t* Qb = (bf16_t*)(ws + WS_QB); bf16_t* Kb = (bf16_t*)(ws + WS_KB); const bf16_t* KV = (const bf16_t*)(ws + WS_KVRAW); const bf16_t* CKV = (const bf16_t*)(ws + WS_CKV);
    const float2* rt = (const float2*)(ws + WS_ROPE);
    const int NGT = lgdim() * 512, gt = lbid() * 512 + ltid(wv), part = gt & 3, pc = part < 3 ? part : 2;
    static_assert((T * NH * 4) % (2 * 256 * 512) == 0, "uniform trip count");
    float g[32];
    { const float* gg = (WHICH ? a.in[9] : a.in[8]) + l * DQK + pc * 32;
#pragma unroll
      for (int d = 0; d < 32; ++d) g[d] = WHICH ? gg[d] : gg[d] * 0.14724448646421766f; }
    bf16_t* dst = WHICH ? Kb : Qb;
    for (int i = gt; i < T * NH * 4; i += 2 * NGT) {
        const int t0 = (i >> 2) >> 3, h0 = (i >> 2) & 7, i1 = i + NGT, t1 = (i1 >> 2) >> 3, h1 = (i1 >> 2) & 7;
        const u32x4* s0 = (const u32x4*)fin_src<WHICH>(Qb, KV, CKV, t0, h0, pc); const u32x4* s1 = (const u32x4*)fin_src<WHICH>(Qb, KV, CKV, t1, h1, pc);
        u32x4 w0[4], w1[4], o0[4], o1[4];
#pragma unroll
        for (int j = 0; j < 4; ++j) { w0[j] = s0[j]; w1[j] = s1[j]; }
        fin_math(w0, g, rt, t0, part, o0); fin_math(w1, g, rt, t1, part, o1);
        if (part < 3) { u32x4* d0 = (u32x4*)(dst + (size_t)t0 * 768 + h0 * 96 + part * 32); u32x4* d1 = (u32x4*)(dst + (size_t)t1 * 768 + h1 * 96 + part * 32);
#pragma unroll
            for (int j = 0; j < 4; ++j) { d0[j] = o0[j]; d1[j] = o1[j]; } }
    }
}
__device__ __forceinline__ void finalize_qk(const Args& a, int l, const int wv) { finalize_pass<true>(a, l, wv); }

__device__ __forceinline__ int crow(int r, int hi) { return (r & 3) + 8 * (r >> 2) + 4 * hi; }
typedef short v4i16_t __attribute__((ext_vector_type(4)));
__device__ __forceinline__ s16x4 vtr(const LAS char* p) { return __builtin_bit_cast(s16x4, __builtin_amdgcn_ds_read_tr16_b64_v4i16((LAS v4i16_t*)p)); }
template <int KC> __device__ __forceinline__ void seqmix_load(u32x4 (&st)[KC / 32], const bf16_t* in, size_t in_stride, int tid) {
    constexpr int KH = KC / 2;
#pragma unroll
    for (int i = 0; i < KC / 32; ++i) { const int id = tid + 512 * i, row = id >> 4, ch = id & 15, p = row / KH, n = row % KH;
        st[i] = *(const u32x4*)(in + (size_t)n * in_stride + p * 512 + ch * 8); }
}
template <int MOUT, int KC, int MH, int ISTR, int OSTR, class Desc>
__device__ __forceinline__ void seqmix_run(unsigned char* lds_g, const Desc D, int first, int step, int nunits, const int wv) {
    constexpr size_t in_stride = ISTR, out_stride = OSTR;
    constexpr int PITCH = 320, NLD = KC / 32, NRB = MOUT / 32, WR = NRB < 8 ? NRB : 8, WCN = 8 / WR, CPW = 4 / WCN, NKS = KC / 16;
    LAS char* lds = (LAS char*)lds_g;
    const int tid = ltid(wv), lane = tid & 63, wid = tid >> 6, r32 = lane & 31, hi = lane >> 5;
    const int rb = wid % WR, cg0 = (wid / WR) * CPW;
    const LAS char* vb = lds + (8 * hi + ((lane >> 2) & 3)) * PITCH + (16 * ((lane >> 4) & 1) + 4 * (lane & 3)) * 2;
    u32x4 st[NLD];
    int u = first;
    if (u < nunits) { const bf16_t* mat; const bf16_t* in; bf16_t* out; D(u, mat, in, out); seqmix_load<KC>(st, in, in_stride, tid); }
    while (u < nunits) {
        const bf16_t* mat; const bf16_t* in; bf16_t* out; D(u, mat, in, out);
        bf16x8 af[NKS];
#pragma unroll
        for (int ks = 0; ks < NKS; ++ks) af[ks] = *(const bf16x8*)(mat + (size_t)(rb * 32 + r32) * KC + ks * 16 + hi * 8);
        __syncthreads();
#pragma unroll
        for (int i = 0; i < NLD; ++i) { const int id = tid + 512 * i, row = id >> 4, ch = id & 15; *(LAS u32x4*)(lds + row * PITCH + ch * 16) = st[i]; }
        __syncthreads();
        const int un = u + step;
        if (un < nunits) { const bf16_t* m2; const bf16_t* in2; bf16_t* o2; D(un, m2, in2, o2); seqmix_load<KC>(st, in2, in_stride, tid); }
        f32x16 acc[CPW];
#pragma unroll
        for (int c = 0; c < CPW; ++c) acc[c] = (f32x16){};
#pragma unroll
        for (int ks = 0; ks < NKS; ++ks)
#pragma unroll
            for (int c = 0; c < CPW; ++c) {
                const s16x4 lo = vtr(vb + ks * 16 * PITCH + (cg0 + c) * 64), h4 = vtr(vb + ks * 16 * PITCH + 4 * PITCH + (cg0 + c) * 64);
                const bf16x8 b = (bf16x8){lo[0], lo[1], lo[2], lo[3], h4[0], h4[1], h4[2], h4[3]};
                acc[c] = __builtin_amdgcn_mfma_f32_32x32x16_bf16(af[ks], b, acc[c], 0, 0, 0);
            }
        { bf16_t* ob = out + (size_t)(((rb * 32) % MH) + 4 * hi) * out_stride + ((rb * 32) / MH) * 512 + cg0 * 32 + r32;
#pragma unroll
          for (int c = 0; c < CPW; ++c)
#pragma unroll
            for (int r = 0; r < 16; ++r) ob[(size_t)((r & 3) + 8 * (r >> 2)) * out_stride + c * 32] = (bf16_t)(cvt_pk(acc[c][r], 0.f) & 0xffffu); }
        u = un;
    }
    __syncthreads();
}
struct DescS1S { bf16_t* VC; const bf16_t* m; __device__ __forceinline__ void operator()(int u, const bf16_t*& mat, const bf16_t*& in, bf16_t*& out) const {
    const int chunk = u & 3, n2 = u >> 2; bf16_t* p = VC + (size_t)(TP + n2) * 1024 + chunk * 128; mat = m; in = p; out = p; } };
struct DescS1P { bf16_t* VC; const bf16_t* m; __device__ __forceinline__ void operator()(int u, const bf16_t*& mat, const bf16_t*& in, bf16_t*& out) const {
    const int chunk = u & 3, n2 = (u >> 2) & 63, b = u >> 8; bf16_t* p = VC + (size_t)(b * 2048 + n2) * 1024 + chunk * 128; mat = m; in = p; out = p; } };
struct DescS2S { const bf16_t* T1; bf16_t* FA; const bf16_t* m; __device__ __forceinline__ void operator()(int u, const bf16_t*& mat, const bf16_t*& in, bf16_t*& out) const {
    const int chunk = u & 3, k1 = u >> 2; mat = m + (size_t)k1 * 128 * 256; in = T1 + (size_t)(TP + 128 * k1) * 1024 + chunk * 128; out = FA + (size_t)(TP + k1) * 1024 + chunk * 128; } };
struct DescS2P { const bf16_t* T1; bf16_t* FA; const bf16_t* m; __device__ __forceinline__ void operator()(int u, const bf16_t*& mat, const bf16_t*& in, bf16_t*& out) const {
    const int chunk = u & 3, k1 = (u >> 2) & 31, b = u >> 7; mat = m + (size_t)k1 * 64 * 128; in = T1 + (size_t)(b * 2048 + 64 * k1) * 1024 + chunk * 128; out = FA + (size_t)(b * 2048 + k1) * 1024 + chunk * 128; } };
__device__ __forceinline__ void fourier_stage1(const Args& a, unsigned char* lds, const int wv) {
    unsigned char* ws = a.ws; bf16_t* VC = (bf16_t*)(ws + WS_VC);
    seqmix_run<256, 256, 128, 128 * 1024, 128 * 1024>(lds, DescS1S{VC, (const bf16_t*)(ws + WS_M1B)}, lbid(), lgdim(), 512, wv);
    seqmix_run<64, 64, 32, 64 * 1024, 64 * 1024>(lds, DescS1P{VC, (const bf16_t*)(ws + WS_M1A)}, lbid(), lgdim(), 8192, wv);
}
__device__ __forceinline__ void fourier_stage2(const Args& a, unsigned char* lds, const int wv) {
    unsigned char* ws = a.ws; const bf16_t* T1 = (const bf16_t*)(ws + WS_VC); bf16_t* FA = (bf16_t*)(ws + WS_FA);
    seqmix_run<128, 256, 128, 1024, 128 * 1024>(lds, DescS2S{T1, FA, (const bf16_t*)(ws + WS_M2B)}, lbid(), lgdim(), 512, wv);
    seqmix_run<64, 128, 64, 1024, 32 * 1024>(lds, DescS2P{T1, FA, (const bf16_t*)(ws + WS_M2A)}, lbid(), lgdim(), 4096, wv);
}

namespace att {
constexpr int NW = 8, QBLK = 32, KVBLK = 64;
constexpr int LDQ = 768, LDK = 768, LDV = 1024, LDO = 1024;
constexpr float SCALE = 0.10206207261596575f;
constexpr float THR = 8.f;
constexpr size_t SHM_V = 64 * 128 * 2, SHM_K = 64 * 256;
#define KSWZ(row, colB) ((row) * 256 + ((colB) ^ (((row) & 7) << 4)))
#define SBAR() __builtin_amdgcn_sched_barrier(0)
#define MX3(a, b, c) __builtin_fmaxf(__builtin_fmaxf((a), (b)), (c))
template <bool FIRST> __device__ __forceinline__ void partialSM(f32x16& p0, f32x16& p1, float& m_reg, f32x16& negm, float& alpha) {
  constexpr float THR2 = THR * 1.4426950408889634f;
  float a = MX3(p0[0], p0[1], p1[0]), b = MX3(p0[2], p0[3], p1[1]); a = MX3(a, p1[2], p1[3]);
#pragma unroll
  for (int r = 4; r < 16; r += 4) { a = MX3(a, p0[r], p0[r + 1]); b = MX3(b, p0[r + 2], p0[r + 3]); a = MX3(a, p1[r], p1[r + 1]); b = MX3(b, p1[r + 2], p1[r + 3]); }
  float pmax = __builtin_fmaxf(a, b);
  { auto rr = __builtin_amdgcn_permlane32_swap(__float_as_uint(pmax), __float_as_uint(pmax), false, false);
    pmax = __builtin_fmaxf(__uint_as_float(rr[0]), __uint_as_float(rr[1])); }
  alpha = 1.f;
  if (FIRST || !__builtin_expect(__all(pmax <= THR2), 1)) {
    const float dl = FIRST ? pmax : __builtin_fmaxf(pmax, 0.f);
    m_reg += dl;
#pragma unroll
    for (int r = 0; r < 16; ++r) { p0[r] -= dl; p1[r] -= dl; }
#pragma unroll
    for (int r = 0; r < 16; ++r) negm[r] = -m_reg;
    if (!FIRST) alpha = __builtin_amdgcn_exp2f(-dl);
  }
#pragma unroll
  for (int r = 0; r < 16; ++r) p0[r] = __builtin_amdgcn_exp2f(p0[r]);
}
__device__ __forceinline__ void finishSM(f32x16& p0, f32x16& p1, float alpha, float& l_reg, bf16x8& pa0, bf16x8& pa1, bf16x8& pa2, bf16x8& pa3) {
#pragma unroll
  for (int r = 0; r < 16; ++r) p1[r] = __builtin_amdgcn_exp2f(p1[r]);
  float ps = 0;
#pragma unroll
  for (int r = 0; r < 16; ++r) ps += p0[r];
#pragma unroll
  for (int r = 0; r < 16; ++r) ps += p1[r];
  { auto rr = __builtin_amdgcn_permlane32_swap(__float_as_uint(ps), __float_as_uint(ps), false, false);
    ps = __uint_as_float(rr[0]) + __uint_as_float(rr[1]); }
  l_reg = l_reg * alpha + ps;
#define PK4(P, BASE, OUT) do { unsigned a0 = cvt_pk(P[BASE + 0], P[BASE + 1]), a1 = cvt_pk(P[BASE + 2], P[BASE + 3]);   \
    unsigned b0 = cvt_pk(P[BASE + 4], P[BASE + 5]), b1 = cvt_pk(P[BASE + 6], P[BASE + 7]);                              \
    auto r0 = __builtin_amdgcn_permlane32_swap(a0, b0, false, false); auto r1 = __builtin_amdgcn_permlane32_swap(a1, b1, false, false); \
    u32x4 w = {r0[0], r1[0], r0[1], r1[1]}; OUT = *reinterpret_cast<bf16x8*>(&w); } while (0)
  PK4(p0, 0, pa0); PK4(p0, 8, pa1); PK4(p1, 0, pa2); PK4(p1, 8, pa3);
#undef PK4
}
__device__ __forceinline__ void qkt(f32x16& p0, f32x16& p1, const char* Ks, const bf16x8* qr, const f32x16& negm, int r32, int hi) {
#pragma unroll
  for (int d0 = 0; d0 < 6; ++d0) { int cb = (d0 * 16 + hi * 8) * 2;
    bf16x8 b0 = *reinterpret_cast<const bf16x8*>(Ks + KSWZ(r32, cb));
    bf16x8 b1 = *reinterpret_cast<const bf16x8*>(Ks + KSWZ(32 + r32, cb));
    p0 = __builtin_amdgcn_mfma_f32_32x32x16_bf16(b0, qr[d0], d0 == 0 ? negm : p0, 0, 0, 0);
    p1 = __builtin_amdgcn_mfma_f32_32x32x16_bf16(b1, qr[d0], d0 == 0 ? negm : p1, 0, 0, 0); }
}
__device__ __forceinline__ int v_st(int k, int c) { const int kk = (k & ~0xC) | ((k & 4) << 1) | ((k & 8) >> 1); return ((kk >> 3) * 4 + (c >> 5)) * 512 + ((kk & 7) * 32 + (c & 31)) * 2; }
__device__ __forceinline__ int v_rd_base(int lane) { return ((lane & 3) << 3) | (((lane >> 2) & 3) << 6) | (((lane >> 4) & 1) << 5) | (((lane >> 5) & 1) << 8); }
constexpr int v_rd_off(int d0, int ks, int half) { return d0 * 512 + ks * 4096 + half * 2048; }
template <int OFF> __device__ __forceinline__ s16x4 tr_read(int vb) {
  s16x4 r; asm volatile("ds_read_b64_tr_b16 %0, %1 offset:%2" : "=&v"(r) : "v"(vb), "i"(OFF) : "memory"); return r;
}
template <int D0> __device__ __forceinline__ void pv_one(f32x16& od, int vb, bf16x8 pa0, bf16x8 pa1, bf16x8 pa2, bf16x8 pa3) {
  const s16x4 l0 = tr_read<v_rd_off(D0, 0, 0)>(vb), h0 = tr_read<v_rd_off(D0, 0, 1)>(vb), l1 = tr_read<v_rd_off(D0, 1, 0)>(vb), h1 = tr_read<v_rd_off(D0, 1, 1)>(vb);
  const s16x4 l2 = tr_read<v_rd_off(D0, 2, 0)>(vb), h2 = tr_read<v_rd_off(D0, 2, 1)>(vb), l3 = tr_read<v_rd_off(D0, 3, 0)>(vb), h3 = tr_read<v_rd_off(D0, 3, 1)>(vb);
  asm volatile("s_waitcnt lgkmcnt(0)" ::: "memory"); SBAR();
#define PK(L, H) (bf16x8){L[0], L[1], L[2], L[3], H[0], H[1], H[2], H[3]}
  od = __builtin_amdgcn_mfma_f32_32x32x16_bf16(pa0, PK(l0, h0), od, 0, 0, 0);
  od = __builtin_amdgcn_mfma_f32_32x32x16_bf16(pa1, PK(l1, h1), od, 0, 0, 0);
  od = __builtin_amdgcn_mfma_f32_32x32x16_bf16(pa2, PK(l2, h2), od, 0, 0, 0);
  od = __builtin_amdgcn_mfma_f32_32x32x16_bf16(pa3, PK(l3, h3), od, 0, 0, 0);
#undef PK
}
__device__ __forceinline__ void pv_d0(f32x16* o, int vb, bf16x8 pa0, bf16x8 pa1, bf16x8 pa2, bf16x8 pa3) {
  pv_one<0>(o[0], vb, pa0, pa1, pa2, pa3); pv_one<1>(o[1], vb, pa0, pa1, pa2, pa3);
}
__device__ __forceinline__ void glds16(const void* gsrc, unsigned lds_dst) { unsigned keep;
  asm volatile("s_mov_b32 %0, m0\n\ts_mov_b32 m0, %2\n\ts_nop 0\n\tglobal_load_lds_dwordx4 %1, off\n\ts_mov_b32 m0, %0" : "=&s"(keep) : "v"(gsrc), "s"(lds_dst) : "memory"); }
#define WAIT_BAR(N) asm volatile("s_waitcnt vmcnt(" #N ") lgkmcnt(0)\n\ts_barrier" ::: "memory")
constexpr int KSLOT = 16384, VSLOT = 8192, LDS_KR = 0, LDS_VR = 4 * KSLOT, LDS_WSF = LDS_VR + 4 * VSLOT;
constexpr int v_rd_off2(int d0, int ks, int half) { return d0 * 512 + ks * 2048 + half * 1024; }
__device__ __forceinline__ void pv2(f32x16* o, int vb, bf16x8 pa0, bf16x8 pa1, bf16x8 pa2, bf16x8 pa3) {
  const s16x4 a0 = tr_read<v_rd_off2(0, 0, 0)>(vb), b0 = tr_read<v_rd_off2(0, 0, 1)>(vb), c0 = tr_read<v_rd_off2(1, 0, 0)>(vb), d0 = tr_read<v_rd_off2(1, 0, 1)>(vb);
  const s16x4 a1 = tr_read<v_rd_off2(0, 1, 0)>(vb), b1 = tr_read<v_rd_off2(0, 1, 1)>(vb), c1 = tr_read<v_rd_off2(1, 1, 0)>(vb), d1 = tr_read<v_rd_off2(1, 1, 1)>(vb);
  const s16x4 a2 = tr_read<v_rd_off2(0, 2, 0)>(vb), b2 = tr_read<v_rd_off2(0, 2, 1)>(vb), c2 = tr_read<v_rd_off2(1, 2, 0)>(vb), d2 = tr_read<v_rd_off2(1, 2, 1)>(vb);
  const s16x4 a3 = tr_read<v_rd_off2(0, 3, 0)>(vb), b3 = tr_read<v_rd_off2(0, 3, 1)>(vb), c3 = tr_read<v_rd_off2(1, 3, 0)>(vb), d3 = tr_read<v_rd_off2(1, 3, 1)>(vb);
  asm volatile("s_waitcnt lgkmcnt(0)" ::: "memory"); SBAR();
#define PK(L, H) (bf16x8){L[0], L[1], L[2], L[3], H[0], H[1], H[2], H[3]}
  o[0] = __builtin_amdgcn_mfma_f32_32x32x16_bf16(pa0, PK(a0, b0), o[0], 0, 0, 0);
  o[1] = __builtin_amdgcn_mfma_f32_32x32x16_bf16(pa0, PK(c0, d0), o[1], 0, 0, 0);
  o[0] = __builtin_amdgcn_mfma_f32_32x32x16_bf16(pa1, PK(a1, b1), o[0], 0, 0, 0);
  o[1] = __builtin_amdgcn_mfma_f32_32x32x16_bf16(pa1, PK(c1, d1), o[1], 0, 0, 0);
  o[0] = __builtin_amdgcn_mfma_f32_32x32x16_bf16(pa2, PK(a2, b2), o[0], 0, 0, 0);
  o[1] = __builtin_amdgcn_mfma_f32_32x32x16_bf16(pa2, PK(c2, d2), o[1], 0, 0, 0);
  o[0] = __builtin_amdgcn_mfma_f32_32x32x16_bf16(pa3, PK(a3, b3), o[0], 0, 0, 0);
  o[1] = __builtin_amdgcn_mfma_f32_32x32x16_bf16(pa3, PK(c3, d3), o[1], 0, 0, 0);
#undef PK
}
__device__ __forceinline__ void attn_unit(const bf16_t* __restrict__ Qb, const bf16_t* __restrict__ Kh, const bf16_t* __restrict__ Vh, bf16_t* __restrict__ Ob, int seq, char* lds, const int wv, const float* __restrict__ gq, const float2* __restrict__ rt, int pos0) {
  const int tid = ltid(wv), wid = wv, lane = tid & 63, r32 = lane & 31, hi = lane >> 5;
  const unsigned lds0 = (unsigned)(uintptr_t)lds;
  float* ws = (float*)(lds + LDS_WSF) + wid * 64; float* li_l = ws; float* al_l = ws + 32;
  float m_reg = 0.f, l_reg = 0; f32x16 o[2] = {}; f32x16 negm = {}; bf16x8 qr[6];
  const bf16_t* Qw = Qb + (long)(wid * QBLK + r32) * LDQ + hi * 8;
  __syncthreads();
  {
    float v[6][8]; float ss = 0.f;
#pragma unroll
    for (int d0 = 0; d0 < 6; ++d0) { const u32x4 w = *reinterpret_cast<const u32x4*>(Qw + d0 * 16);
      v[d0][0] = bf_lo(w.x); v[d0][1] = bf_hi(w.x); v[d0][2] = bf_lo(w.y); v[d0][3] = bf_hi(w.y); v[d0][4] = bf_lo(w.z); v[d0][5] = bf_hi(w.z); v[d0][6] = bf_lo(w.w); v[d0][7] = bf_hi(w.w);
#pragma unroll
      for (int j = 0; j < 8; ++j) ss += v[d0][j] * v[d0][j]; }
    ss += __shfl_xor(ss, 32);
    const float r = (1.0f / sqrtf(ss * (1.0f / 96.0f) + EPS));
#pragma unroll
    for (int d0 = 0; d0 < 6; ++d0)
#pragma unroll
      for (int j = 0; j < 8; ++j) v[d0][j] = v[d0][j] * r * gq[d0 * 16 + hi * 8 + j];
    const int pos = pos0 + wid * QBLK + r32;
#pragma unroll
    for (int j = 0; j < 8; ++j) { const float2 cs = rt[pos * 16 + hi * 8 + j]; const float x1 = v[4][j], x2 = v[5][j]; v[4][j] = x1 * cs.x - x2 * cs.y; v[5][j] = x2 * cs.x + x1 * cs.y; }
    constexpr float CQ = 0.14724448646421766f;
#pragma unroll
    for (int d0 = 0; d0 < 6; ++d0) { u32x4 w; w.x = cvt_pk(v[d0][0] * CQ, v[d0][1] * CQ); w.y = cvt_pk(v[d0][2] * CQ, v[d0][3] * CQ); w.z = cvt_pk(v[d0][4] * CQ, v[d0][5] * CQ); w.w = cvt_pk(v[d0][6] * CQ, v[d0][7] * CQ);
      qr[d0] = __builtin_bit_cast(bf16x8, w); }
  }
  const int kq = lane >> 4, kc0 = (lane & 15) ^ kq, kc1 = (lane & 15) ^ (4 + kq);
  const char* ksrc0 = (const char*)Kh + (size_t)(8 * wid + kq) * (LDK * 2) + (kc0 > 11 ? 11 : kc0) * 16;
  const char* ksrc1 = (const char*)Kh + (size_t)(8 * wid + 4 + kq) * (LDK * 2) + (kc1 > 11 ? 11 : kc1) * 16;
  const int vkk = 8 * wid + ((lane & 31) >> 2), vk = (vkk & ~0xC) | ((vkk & 4) << 1) | ((vkk & 8) >> 1);
  const char* vsrc = (const char*)Vh + (size_t)vk * (LDV * 2) + (32 * (lane >> 5) + 8 * (lane & 3)) * 2;
  const unsigned kdst = lds0 + LDS_KR + wid * 2048, vdst = lds0 + LDS_VR + wid * 1024;
#define DMA_K(t, slot) do { const size_t o_ = (size_t)(t) * (KVBLK * LDK * 2); const unsigned d_ = (unsigned)__builtin_amdgcn_readfirstlane(kdst + (slot) * KSLOT); glds16(ksrc0 + o_, d_); glds16(ksrc1 + o_, d_ + 1024u); } while (0)
#define DMA_V(t, slot) glds16(vsrc + (size_t)(t) * (KVBLK * LDV * 2), (unsigned)__builtin_amdgcn_readfirstlane(vdst + (slot) * VSLOT))
#define RESC(a) do { if (__any((a) < 1.f)) { if (hi == 0) al_l[r32] = (a); asm volatile("s_waitcnt lgkmcnt(0)" ::: "memory"); \
    _Pragma("unroll") for (int d = 0; d < 2; ++d) _Pragma("unroll") for (int r = 0; r < 16; ++r) o[d][r] *= al_l[crow(r, hi)]; } } while (0)
  const int vb0 = (int)lds0 + LDS_VR + v_rd_base(lane);
  f32x16 pA0, pA1, pB0, pB1; float alA, alB; bf16x8 pa0, pa1, pa2, pa3; const int NT = seq / KVBLK;
  DMA_K(0, 0); DMA_K(1, 1); DMA_V(0, 0);
  WAIT_BAR(0);
#define STEP(C0, C1, alC, P0, P1, alP, t) do { \
    SBAR(); qkt(C0, C1, lds + LDS_KR + ((t) & 3) * KSLOT, qr, negm, r32, hi); \
    finishSM(P0, P1, alP, l_reg, pa0, pa1, pa2, pa3); SBAR(); \
    pv2(o, vb0 + (((t) - 1) & 3) * VSLOT, pa0, pa1, pa2, pa3); partialSM<false>(C0, C1, m_reg, negm, alC); \
    RESC(alC); } while (0)
  DMA_K(2, 2); DMA_K(3, 3); DMA_V(1, 1); DMA_V(2, 2);
  qkt(pA0, pA1, lds + LDS_KR, qr, negm, r32, hi); partialSM<true>(pA0, pA1, m_reg, negm, alA);
  STEP(pB0, pB1, alB, pA0, pA1, alA, 1);
  WAIT_BAR(0);
  for (int t = 2; t < NT; t += 2) {
    if (t + 2 < NT) { DMA_K(t + 2, (t + 2) & 3); DMA_K(t + 3, (t + 3) & 3); }
    if (t + 1 < NT) DMA_V(t + 1, (t + 1) & 3); if (t + 2 < NT) DMA_V(t + 2, (t + 2) & 3);
    STEP(pA0, pA1, alA, pB0, pB1, alB, t);
    STEP(pB0, pB1, alB, pA0, pA1, alA, t + 1);
    WAIT_BAR(0);
  }
  finishSM(pB0, pB1, alB, l_reg, pa0, pa1, pa2, pa3); SBAR();
  pv2(o, vb0 + ((NT - 1) & 3) * VSLOT, pa0, pa1, pa2, pa3);
  if (hi == 0) li_l[r32] = l_reg; asm volatile("s_waitcnt lgkmcnt(0)" ::: "memory");
  float rli[16];
#pragma unroll
  for (int r = 0; r < 16; ++r) rli[r] = __builtin_amdgcn_rcpf(li_l[crow(r, hi)]);
  bf16_t* Ow = Ob + (long)(wid * QBLK) * LDO;
#pragma unroll
  for (int r = 0; r < 16; ++r) { const int orow = crow(r, hi);
#pragma unroll
    for (int d0 = 0; d0 < 2; ++d0) Ow[(long)orow * LDO + d0 * 32 + r32] = (bf16_t)(cvt_pk(o[d0][r] * rli[r], 0.f) & 0xffffu); }
  asm volatile("s_waitcnt lgkmcnt(0)\n\ts_barrier" ::: "memory");
#undef DMA_K
#undef DMA_V
#undef RESC
#undef STEP
}
#undef SBAR
}

__device__ __forceinline__ void attention_phase(const Args& a, unsigned char* lds, const int wv, int l) {
    unsigned char* ws = a.ws; const float* gq = a.in[8] + l * DQK; const float2* rt = (const float2*)(ws + WS_ROPE);
    const bf16_t* Qb = (const bf16_t*)(ws + WS_QB); const bf16_t* Kb = (const bf16_t*)(ws + WS_KB); const bf16_t* KV = (const bf16_t*)(ws + WS_KVRAW); bf16_t* FA = (bf16_t*)(ws + WS_FA);
    const int G = lgdim();
    for (int u = lbid(); u < 512; u += G) { const int h = u & 7, qb = u >> 3; const size_t t0 = TP;
        att::attn_unit(Qb + (t0 + (size_t)qb * 256) * 768 + h * 96, Kb + t0 * 768 + h * 96, KV + t0 * 1024 + h * 128 + 64, FA + (t0 + (size_t)qb * 256) * 1024 + 512 + h * 64, 16384, (char*)lds, wv, gq, rt, qb * 256); }
    for (int u = lbid() * 8; u < 2048; u += G * 8)
        for (int qb = 0; qb < 8; ++qb) { const int bh = u >> 3, b = bh >> 3, h = bh & 7; const size_t t0 = (size_t)b * 2048;
            att::attn_unit(Qb + (t0 + (size_t)qb * 256) * 768 + h * 96, Kb + t0 * 768 + h * 96, KV + t0 * 1024 + h * 128 + 64, FA + (t0 + (size_t)qb * 256) * 1024 + 512 + h * 64, 2048, (char*)lds, wv, gq, rt, qb * 256); }
    __syncthreads();
}


typedef const __attribute__((address_space(4))) Args* KArgs;
extern __shared__ __attribute__((aligned(16))) unsigned char lds_dyn[];

#define XB_TMO      128
#define XB_XCNT(j)  (256  + 64 * (j))
#define XB_XSUB(j)  (1280 + 64 * (j))
#define XB_XGEN(j)  (2304 + 64 * (j))
#define XB_TOP      3328
#define XB_TOPGEN   3392
#define XCD_BAR_WORDS 3456
#define XB_SPIN_CAP (1u << 18)
__device__ __forceinline__ unsigned xb_ld(unsigned* p)              { return __hip_atomic_load(p, __ATOMIC_RELAXED, __HIP_MEMORY_SCOPE_AGENT); }
__device__ __forceinline__ unsigned xb_add(unsigned* p, unsigned v) { return __hip_atomic_fetch_add(p, v, __ATOMIC_RELAXED, __HIP_MEMORY_SCOPE_AGENT); }
__device__ __forceinline__ unsigned xb_xcc_id() { return (unsigned)__builtin_amdgcn_s_getreg((3 << 11) | 20) & 0xFu; }
#define XB_SPIN(cond, bar) do { unsigned _sp = 0; while (cond) { __builtin_amdgcn_s_sleep(1); \
    if ((++_sp & 255u) == 0u) { if (xb_ld(&(bar)[XB_TMO])) break; if (_sp > XB_SPIN_CAP) { atomicAdd(&(bar)[XB_TMO], 1u); break; } } } } while (0)
__device__ __forceinline__ void xcd_barrier_complete(unsigned* bar, unsigned x, unsigned& nloc, unsigned& nx) {
    const unsigned G = gridDim.x * gridDim.y * gridDim.z;
    unsigned sum, cnt, mine, sp = 0u;
    for (;;) {
        sum = 0u; cnt = 0u; mine = 0u;
#pragma unroll
        for (unsigned j = 0; j < 16; ++j) { const unsigned c = xb_ld(&bar[XB_XCNT(j)]); sum += c; cnt += (c > 0u) ? 1u : 0u; mine = (j == x) ? c : mine; }
        if (sum == G) break;
        __builtin_amdgcn_s_sleep(1);
        if ((++sp & 255u) == 0u) { if (xb_ld(&bar[XB_TMO])) break; if (sp > XB_SPIN_CAP) { atomicAdd(&bar[XB_TMO], 1u); break; } }
    }
    nloc = mine > 0u ? mine : 1u; nx = cnt > 0u ? cnt : 1u;
}
__device__ __forceinline__ void grid_barrier(unsigned* bar, volatile LAS unsigned* st, const int wv) {
    asm volatile("s_waitcnt vmcnt(0)" ::: "memory");
    __syncthreads();
    if (ltid(wv) == 0) {
        const unsigned x = xb_xcc_id();
        __builtin_amdgcn_s_waitcnt(0);
        unsigned nloc = st[0], nx = st[1];
        if (nloc == 0u) { xcd_barrier_complete(bar, x, nloc, nx); st[0] = nloc; st[1] = nx; }
        const unsigned old = xb_add(&bar[XB_XSUB(x)], 1u);
        const unsigned gen = old / nloc;
        if (old + 1u == (gen + 1u) * nloc) {
            __builtin_amdgcn_fence(__ATOMIC_RELEASE, "agent");
            asm volatile("s_waitcnt vmcnt(0)" ::: "memory");
            const unsigned og = xb_add(&bar[XB_TOP], 1u);
            const unsigned tg = og / nx;
            if (og + 1u == (tg + 1u) * nx) xb_add(&bar[XB_TOPGEN], 1u);
            else XB_SPIN(xb_ld(&bar[XB_TOPGEN]) == tg, bar);
            __builtin_amdgcn_fence(__ATOMIC_ACQUIRE, "agent");
            xb_add(&bar[XB_XGEN(x)], 1u);
            asm volatile("s_waitcnt vmcnt(0)" ::: "memory");
        } else {
            XB_SPIN(xb_ld(&bar[XB_XGEN(x)]) == gen, bar);
            __builtin_amdgcn_fence(__ATOMIC_ACQUIRE, "agent");
            asm volatile("s_waitcnt vmcnt(0)" ::: "memory");
        }
    }
    __syncthreads();
}

constexpr int LDS_BYTES = 131072 + 64;
constexpr int N_PHASES = 17;
#ifndef PH_MASK
#define PH_MASK 0xfff
#endif
#define EN(k) (((PH_MASK) >> (k)) & 1)
#ifndef PROBE_PH
#define PROBE_PH -1
#endif
#ifndef PROBE_OFF0
#define PROBE_OFF0 230
#endif
#ifndef PROBE_OFF1
#define PROBE_OFF1 -1
#endif
#ifndef PROBE_N1
#define PROBE_N1 0
#endif
#ifndef MK_PER_PHASE
#define MK_PER_PHASE 0
#endif
template <class Epi> __device__ __forceinline__ void run_gemm(unsigned char* lds, const bf16_t* A, int lda, const bf16_t* Bt, int ldb, int N, int K, const Epi& E, const int wv, const int ablk = 0) {
    asm volatile("" : "+s"(K));
    pg8::Gemm g{A, Bt, T, N, K, lda, ldb, ablk}; pg8::StaticOrder S; S.init(T, N, lgdim(), lbid());
    pg8::gemm_phase<Epi, pg8::StaticOrder, true, true>((LAS unsigned char*)lds, g, S, E, wv);
}
__device__ __forceinline__ void do_phase(const Args& a_, const int ph, unsigned char* lds, const int wv) {
#if defined(__HIP_DEVICE_COMPILE__)
        const __attribute__((address_space(4))) Args* ap = (const __attribute__((address_space(4))) Args*)__builtin_amdgcn_kernarg_segment_ptr(); asm volatile("" : "+s"(ap));
        const Args a = *ap;
#else
        const Args a = a_;
#endif
        unsigned char* ws = a.ws;
        u64* ssq_all = (u64*)(ws + WS_SSQ);
        bf16_t* AB = (bf16_t*)(ws + WS_AB);
#if PROBE_PH >= 0
        if (ph == 100) {
            const bf16_t* b0 = (const bf16_t*)(ws + PROBE_OFF0 * MiB); const bf16_t* b1 = (const bf16_t*)(ws + PROBE_OFF1 * MiB);
            for (size_t i = (size_t)lbid() * 512 + ltid(wv); i < (size_t)T * DM; i += (size_t)lgdim() * 512) {
                float v = __uint_as_float((unsigned)b0[i] << 16); if (PROBE_OFF1 >= 0 && i < (size_t)PROBE_N1) v += __uint_as_float((unsigned)b1[i] << 16);
                a.out[i] = v; }
        } else
#endif
        if (ph == 0) { if (EN(9)) p0_prologue(a, lds, wv); }
        else {
            const int l = (ph - 1) / 8, j0 = (ph - 1) % 8, j = j0 < 4 ? j0 : j0 + 1;
            unsigned char* wl = ws + WS_W + (size_t)l * W_LAYER;
            u64* ssq_x = ssq_all + (size_t)(l * 4 + 0) * T; u64* ssq_q = ssq_all + (size_t)(l * 4 + 1) * T; u64* ssq_kv = ssq_all + (size_t)(l * 4 + 2) * T; u64* ssq_h = ssq_all + (size_t)(l * 4 + 3) * T;
            if (j == 0 && EN(0)) {
                EpiIn E{(bf16_t*)(ws + WS_VC), (bf16_t*)(ws + WS_CQ), (bf16_t*)(ws + WS_CKV), ssq_x, ssq_q, ssq_kv, (bf16_t*)a.out};
                run_gemm(lds, AB, 1024, (const bf16_t*)(wl + WO_IN1), 1024, 3584, 1024, E, wv);
            } else if (j == 1 && EN(1)) {
                { EpiRowScale<0> E{(bf16_t*)(ws + WS_QB), 768, ssq_q, 1.0f / 256.0f}; run_gemm(lds, (const bf16_t*)(ws + WS_CQ), 256, (const bf16_t*)(wl + WO_UQ), 256, 768, 256, E, wv); }
                { EpiRowScale<3> E{(bf16_t*)(ws + WS_KVRAW), 1024, ssq_kv, 1.0f / 128.0f}; run_gemm(lds, (const bf16_t*)(ws + WS_CKV), 256, (const bf16_t*)(wl + WO_UKV), 128, 1024, 128, E, wv); }
            } else if (j == 2) {
                if (EN(2)) finalize_qk(a, l, wv); if (EN(10)) fourier_stage1(a, lds, wv);
            } else if (j == 3) {
                if (EN(3)) attention_phase(a, lds, wv, l); if (EN(11)) fourier_stage2(a, lds, wv);
            } else if (j == 4 && EN(4)) {
                EpiRowScale<1> E{(bf16_t*)(ws + WS_GG), 2048, ssq_x, 1.0f / 1024.0f};
                run_gemm(lds, AB, 1024, (const bf16_t*)(wl + WO_G), 1024, 2048, 1024, E, wv);
            } else if (j == 5 && EN(5)) {
                { EpiMixK E{(bf16_t*)(ws + WS_MB), (const bf16_t*)a.out}; run_gemm(lds, (const bf16_t*)(ws + WS_FA), 1024, (const bf16_t*)(wl + WO_OF), 1024, 1024, 1024, E, wv); }
            } else if (j == 6 && EN(6)) {
                if (l == 0) { EpiResid<false, true, false> E{a.in[0], a.in[1], nullptr, AB, ssq_h}; run_gemm(lds, (const bf16_t*)(ws + WS_MB), 1024, (const bf16_t*)(wl + WO_OUT), 1024, 1024, 1024, E, wv); }
                else { EpiResid<true, true, false> E{nullptr, nullptr, nullptr, AB, ssq_h}; run_gemm(lds, (const bf16_t*)(ws + WS_MB), 1024, (const bf16_t*)(wl + WO_OUT), 1024, 1024, 1024, E, wv); }
            } else if (j == 7 && EN(7)) {
                EpiRowScale<2, true> E{(bf16_t*)(ws + WS_UB), 4096, ssq_h, 1.0f / 1024.0f};
                run_gemm(lds, AB, 1024, (const bf16_t*)(wl + WO_UP), 1024, 4096, 1024, E, wv);
            } else if (j == 8 && EN(8)) {
                if (l == 0) { EpiResid<true, true, false> E{nullptr, nullptr, nullptr, AB, ssq_all + (size_t)4 * T}; run_gemm(lds, (const bf16_t*)(ws + WS_UB), 4096, (const bf16_t*)(wl + WO_DN), 4096, 1024, 4096, E, wv, 1); }
                else { EpiResid<true, false, true> E{nullptr, nullptr, a.out, AB, nullptr}; run_gemm(lds, (const bf16_t*)(ws + WS_UB), 4096, (const bf16_t*)(wl + WO_DN), 4096, 1024, 4096, E, wv, 1); }
            }
        }
}
__global__ void __launch_bounds__(512, 2) mega_fwd(Args a_) {
    unsigned char* lds = lds_dyn;
    cg::grid_group grid = cg::this_grid();
    const int ph_lo = a_.ph_lo, ph_hi = a_.ph_hi;
    const int wv = __builtin_amdgcn_readfirstlane((int)threadIdx.x >> 6);
    unsigned* bar = (unsigned*)(a_.ws + WS_BAR);
    volatile LAS unsigned* bst = (volatile LAS unsigned*)((LAS unsigned char*)lds + 131072);
    if (threadIdx.x == 0) { bst[0] = 0u; bst[1] = 0u; (void)xb_add(&bar[XB_XCNT(xb_xcc_id())], 1u); }
    __syncthreads();
    if (ph_hi < 0) grid.sync();
#define STEP(k) if (ph_lo <= (k) && (k) < ph_hi) { do_phase(a_, (k), lds, wv); if ((k) + 1 < ph_hi) grid_barrier(bar, bst, wv); }
    STEP(0) STEP(1) STEP(2) STEP(3) STEP(4) STEP(5) STEP(6) STEP(7) STEP(8) STEP(9) STEP(10) STEP(11) STEP(12) STEP(13) STEP(14) STEP(15) STEP(16)
#if PROBE_PH >= 0
    STEP(100)
#endif
#undef STEP
}

extern "C" void kernel_launch(void* const* d_in, const int* in_sizes, int n_in, void* d_out, int out_size, void* d_ws, size_t ws_size, hipStream_t stream) {
    static int grid = 0;
    if (grid == 0) {
        if (n_in != 16 || out_size != T * DM || ws_size < WS_END) { fprintf(stderr, "kernel_launch: unexpected shapes (n_in %d out %d ws %zu, need ws >= %zu)\n", n_in, out_size, ws_size, (size_t)WS_END); grid = -1; return; }
        int dev = 0, cus = 0, per_cu = 0;
        if (hipGetDevice(&dev) != hipSuccess || hipDeviceGetAttribute(&cus, hipDeviceAttributeMultiprocessorCount, dev) != hipSuccess) { fprintf(stderr, "kernel_launch: device query failed\n"); grid = -1; return; }
        if (hipFuncSetAttribute((const void*)mega_fwd, hipFuncAttributeMaxDynamicSharedMemorySize, LDS_BYTES) != hipSuccess) { fprintf(stderr, "kernel_launch: hipFuncSetAttribute failed\n"); grid = -1; return; }
        if (hipOccupancyMaxActiveBlocksPerMultiprocessor(&per_cu, (const void*)mega_fwd, 512, LDS_BYTES) != hipSuccess || per_cu < 1) { fprintf(stderr, "kernel_launch: occupancy query says %d\n", per_cu); per_cu = 1; }
        (void)hipGetLastError();
        grid = cus;
        if (grid % 8 != 0 || grid <= 0) { fprintf(stderr, "kernel_launch: unexpected CU count %d\n", cus); grid = -1; return; }
    }
    if (grid < 0) return;
    if (hipMemsetAsync((char*)d_ws + WS_BAR, 0, 16384, stream) != hipSuccess) { fprintf(stderr, "kernel_launch: memset failed\n"); return; }
    Args a{};
    for (int i = 0; i < 16; ++i) a.in[i] = (const float*)d_in[i];
    a.out = (float*)d_out; a.ws = (unsigned char*)d_ws;
#if MK_PER_PHASE
    for (int ph = 0; ph < N_PHASES; ++ph) { if (PROBE_PH >= 0 && ph > PROBE_PH) break; a.ph_lo = ph; a.ph_hi = ph + 1; hipLaunchKernelGGL(mega_fwd, dim3(grid), dim3(512), LDS_BYTES, stream, a); }
    if (PROBE_PH >= 0) { a.ph_lo = 100; a.ph_hi = 101; hipLaunchKernelGGL(mega_fwd, dim3(grid), dim3(512), LDS_BYTES, stream, a); }
#else
    a.ph_lo = 0; a.ph_hi = N_PHASES;
    void* args[] = {&a};
    hipError_t e = hipLaunchCooperativeKernel((const void*)mega_fwd, dim3(grid), dim3(512), args, LDS_BYTES, stream);
    if (e != hipSuccess) fprintf(stderr, "cooperative launch failed: %s (grid %d)\n", hipGetErrorString(e), grid);
#endif
}
```

```cpp
#include <hip/hip_runtime.h>
#include <hip/hip_cooperative_groups.h>
#include <cstdio>
#include <cstdint>
namespace cg = cooperative_groups;
__device__ __forceinline__ int lbid() { int b = blockIdx.x; asm volatile("" : "+s"(b)); return b; }
__device__ __forceinline__ int lgdim() { int g = gridDim.x; asm volatile("" : "+s"(g)); return g; }
__device__ __forceinline__ int ltid(int wv) { int t = (wv << 6) | (int)__builtin_amdgcn_mbcnt_hi(~0u, __builtin_amdgcn_mbcnt_lo(~0u, 0u)); asm volatile("" : "+v"(t)); return t; }
namespace pg8 {
#define PG8_LAS __attribute__((address_space(3)))
typedef unsigned short bf16_t;
typedef short bf16x8 __attribute__((ext_vector_type(8)));
typedef float f32x4 __attribute__((ext_vector_type(4)));
typedef unsigned u32x4 __attribute__((ext_vector_type(4)));
constexpr int BM = 256, BK = 64, HALF = 128, HTB = HALF * BK * 2  , STAGE_BYTES = 8 * HTB, NXCD = 8, WGM = 8;

__host__ __device__ __forceinline__ int lds_byte(int r, int c) { const int st = (r >> 4) * 2 + (c >> 5), rr = r & 15, cc = c & 31, ob = rr * 64 + cc * 2; return st * 1024 + (ob ^ (((ob >> 9) & 1) << 5)); }
__host__ __device__ __forceinline__ void stage_rc(int b, int& R, int& C) { const int st = b / 1024, sb = b % 1024, swz = sb ^ (((sb >> 9) & 1) << 5); R = (st >> 1) * 16 + swz / 64; C = (st & 1) * 32 + (swz % 64) / 2; }
__host__ __device__ __forceinline__ int perm32(int rho) { const int n = rho >> 4, i = rho & 15; return 8 * (i >> 2) + 4 * n + (i & 3); }

struct Unit { int pm, pn; };
struct Gemm { const bf16_t* A; const bf16_t* Bt; int M, N, K, lda, ldb, ablk; };

struct StaticOrder {
    int nM, nN, nwg, G, c;
    __host__ __device__ void init(int M, int N, int G_, int c_) { nM = M / BM; nN = N / BM; nwg = nM * nN; G = G_; c = c_; }
    __host__ __device__ bool next(int i, Unit& u) const {
        const long L = (long)i * G + c; if (L >= nwg) return false;
        int wgid = (int)L; { const int q = nwg / NXCD, r = nwg % NXCD, xcd = wgid % NXCD, off = wgid / NXCD; wgid = (xcd < r ? xcd * (q + 1) : r * (q + 1) + (xcd - r) * q) + off; }
        const int nig = WGM * nN, gid = wgid / nig, fm = gid * WGM, gsz = (nM - fm) < WGM ? (nM - fm) : WGM;
        u.pm = fm + ((wgid % nig) % gsz); u.pn = (wgid % nig) / gsz; return true;
    }
    __device__ __forceinline__ void a_ready(const Unit&) const {}
    __device__ __forceinline__ void done(const Unit&) const {}
};


template <class Epi, class Sched, bool ALIGN_EPI = false, bool SP2 = false>
__device__ __forceinline__ void gemm_phase(PG8_LAS unsigned char* lds, const Gemm g, const Sched& S, const Epi& E, const int wv) {
    const int tid = ltid(wv), wid = __builtin_amdgcn_readfirstlane(tid >> 6), lane = tid & 63, wr = wid >> 2, wc = wid & 3, fr = lane & 15, fq = lane >> 4;
    const int K = g.K, nt = K / BK;
    unsigned voffA[2], voffB[2];
#pragma unroll
    for (int i = 0; i < 2; ++i) { int R, C; stage_rc(tid * 16 + i * 8192, R, C); const int Rb = Epi::PERM ? ((R & ~31) + perm32(R & 31)) : R;
        voffA[i] = (unsigned)(R * (g.ablk ? BK : g.lda) + C) * 2u; voffB[i] = (unsigned)(Rb * g.ldb + C) * 2u; }
    const size_t kstepB = (size_t)(BK * 2), kstepA = g.ablk ? (size_t)(BM * BK * 2) : kstepB;
    const size_t hstepA = (size_t)HALF * (g.ablk ? BK : g.lda) * 2, hstepB = (size_t)HALF * g.ldb * 2;
    const size_t tstepA = g.ablk ? (size_t)(K / BK) * (BM * BK * 2) : 2 * hstepA, tstepB = 2 * hstepB;
    const unsigned ldsw = (unsigned)wid * 1024u;
    const int aoff = lds_byte(wr * 64 + fr, fq * 8), boff = lds_byte(wc * 32 + fr, fq * 8);
#define PG8_SA(b, h) (((b) * 2 + (h)) * HTB)
#define PG8_SB(b, h) ((4 + (b) * 2 + (h)) * HTB)
#define PG8_STAGE(bufoff, gbase, voff) do { _Pragma("unroll") for (int _i = 0; _i < 2; ++_i) \
        __builtin_amdgcn_global_load_lds((const unsigned*)((const char*)(gbase) + (voff)[_i]), (PG8_LAS unsigned*)(lds + (bufoff) + ldsw + _i * 8192), 16, 0, 0); } while (0)
#define PG8_LDA(dst, b, h) do { _Pragma("unroll") for (int m = 0; m < 4; ++m) _Pragma("unroll") for (int k = 0; k < 2; ++k) dst[m][k] = *(const PG8_LAS bf16x8*)(lds + PG8_SA(b, h) + aoff + m * 2048 + k * 1024); } while (0)
#define PG8_LDB(dst, b, h) do { _Pragma("unroll") for (int n = 0; n < 2; ++n) _Pragma("unroll") for (int k = 0; k < 2; ++k) dst[n][k] = *(const PG8_LAS bf16x8*)(lds + PG8_SB(b, h) + boff + n * 2048 + k * 1024); } while (0)
#define PG8_MMA(ai, bj, At, Bt) do { __builtin_amdgcn_s_setprio(1); _Pragma("unroll") for (int m = 0; m < 4; ++m) _Pragma("unroll") for (int n = 0; n < 2; ++n) _Pragma("unroll") for (int k = 0; k < 2; ++k) \
        acc[ai][bj][m][n] = __builtin_amdgcn_mfma_f32_16x16x32_bf16(Bt[n][k], At[m][k], acc[ai][bj][m][n], 0, 0, 0); __builtin_amdgcn_s_setprio(0); } while (0)
#define PG8_WAIT_V(n) asm volatile("s_waitcnt vmcnt(" #n ")" ::: "memory")
#define PG8_WAIT_L(n) asm volatile("s_waitcnt lgkmcnt(" #n ")" ::: "memory")
#define PG8_BAR __builtin_amdgcn_s_barrier()
#define PG8_SCHED __builtin_amdgcn_sched_barrier(0)
    Unit cur, nxt; int ui = 0;
    if (!S.next(0, cur)) return;
    f32x4 acc[2][2][4][2];
#pragma unroll
    for (int a = 0; a < 2; ++a)
#pragma unroll
        for (int b = 0; b < 2; ++b)
#pragma unroll
            for (int m = 0; m < 4; ++m)
#pragma unroll
                for (int n = 0; n < 2; ++n) acc[a][b][m][n] = (f32x4){0.f, 0.f, 0.f, 0.f};
    bf16x8 At[4][2], B0[2][2], B1[2][2];
    const char* cA = (const char*)g.A + (size_t)cur.pm * tstepA; const char* cB = (const char*)g.Bt + (size_t)cur.pn * tstepB;
    S.a_ready(cur);
    if constexpr (SP2) {
        PG8_STAGE(PG8_SB(0, 0), cB, voffB); PG8_STAGE(PG8_SB(0, 1), cB + hstepB, voffB); PG8_STAGE(PG8_SA(0, 0), cA, voffA); PG8_STAGE(PG8_SA(0, 1), cA + hstepA, voffA);
        if (wr == 1) PG8_BAR;
        PG8_WAIT_V(2); PG8_BAR;
        PG8_STAGE(PG8_SB(1, 0), cB + kstepB, voffB); PG8_STAGE(PG8_SA(1, 0), cA + kstepA, voffA); PG8_STAGE(PG8_SB(1, 1), cB + hstepB + kstepB, voffB);
        PG8_WAIT_V(6); PG8_BAR;
    } else {
        PG8_STAGE(PG8_SB(0, 0), cB, voffB); PG8_STAGE(PG8_SA(0, 0), cA, voffA); PG8_STAGE(PG8_SB(0, 1), cB + hstepB, voffB); PG8_STAGE(PG8_SA(0, 1), cA + hstepA, voffA);
        if (wr == 1) PG8_BAR;
        PG8_WAIT_V(4); PG8_BAR;
        PG8_STAGE(PG8_SB(1, 0), cB + kstepB, voffB); PG8_STAGE(PG8_SA(1, 0), cA + kstepA, voffA); PG8_STAGE(PG8_SB(1, 1), cB + hstepB + kstepB, voffB);
        PG8_WAIT_V(6); PG8_BAR;
    }
    for (;;) {
        const bool has_next = S.next(ui + 1, nxt);
        const char* nA = has_next ? (const char*)g.A + (size_t)nxt.pm * tstepA : cA; const char* nB = has_next ? (const char*)g.Bt + (size_t)nxt.pn * tstepB : cB;
        for (int t = 0; t < nt; t += 2) {
            const bool last = (t == nt - 2);
            const char* a1 = cA + (size_t)(t + 1) * kstepA;
            const char* a2 = last ? nA : cA + (size_t)(t + 2) * kstepA; const char* b2 = last ? nB : cB + (size_t)(t + 2) * kstepB;
            const char* a3 = a2 + kstepA; const char* b3 = b2 + kstepB;
            if (last && has_next) S.a_ready(nxt);
            if constexpr (SP2) {
            PG8_LDB(B0, 0, 0); PG8_LDB(B1, 0, 1); PG8_SCHED; PG8_LDA(At, 0, 0); PG8_STAGE(PG8_SA(1, 1), a1 + hstepA, voffA);
            PG8_WAIT_V(8); PG8_WAIT_L(0); PG8_BAR; PG8_MMA(0, 0, At, B0); PG8_MMA(0, 1, At, B1); PG8_BAR; PG8_SCHED;
            PG8_LDA(At, 0, 1); PG8_STAGE(PG8_SB(0, 0), b2, voffB); PG8_STAGE(PG8_SB(0, 1), b2 + hstepB, voffB); PG8_STAGE(PG8_SA(0, 0), a2, voffA);
            PG8_WAIT_V(8); PG8_WAIT_L(0); PG8_BAR; PG8_MMA(1, 0, At, B0); PG8_MMA(1, 1, At, B1); PG8_BAR; PG8_SCHED;
            PG8_LDB(B0, 1, 0); PG8_LDB(B1, 1, 1); PG8_SCHED; PG8_LDA(At, 1, 0); PG8_STAGE(PG8_SA(0, 1), a2 + hstepA, voffA);
            PG8_WAIT_V(8); PG8_WAIT_L(0); PG8_BAR; PG8_MMA(0, 0, At, B0); PG8_MMA(0, 1, At, B1); PG8_BAR; PG8_SCHED;
            PG8_LDA(At, 1, 1); PG8_STAGE(PG8_SB(1, 0), b3, voffB); PG8_STAGE(PG8_SB(1, 1), b3 + hstepB, voffB); PG8_STAGE(PG8_SA(1, 0), a3, voffA);
            PG8_WAIT_V(8); PG8_WAIT_L(0); PG8_BAR; PG8_MMA(1, 0, At, B0); PG8_MMA(1, 1, At, B1); PG8_BAR; PG8_SCHED;
            } else {
            PG8_LDB(B0, 0, 0); PG8_SCHED; PG8_LDA(At, 0, 0); PG8_STAGE(PG8_SA(1, 1), a1 + hstepA, voffA);
            PG8_WAIT_L(8); PG8_BAR; PG8_WAIT_L(0); PG8_MMA(0, 0, At, B0); PG8_BAR; PG8_SCHED;
            PG8_LDB(B1, 0, 1); PG8_STAGE(PG8_SB(0, 0), b2, voffB);
            PG8_BAR; PG8_WAIT_L(0); PG8_MMA(0, 1, At, B1); PG8_BAR;
            PG8_LDA(At, 0, 1); PG8_STAGE(PG8_SA(0, 0), a2, voffA);
            PG8_BAR; PG8_WAIT_L(0); PG8_MMA(1, 0, At, B0); PG8_BAR; PG8_SCHED;
            PG8_STAGE(PG8_SB(0, 1), b2 + hstepB, voffB);
            PG8_WAIT_V(6); PG8_BAR; PG8_MMA(1, 1, At, B1); PG8_BAR;
            PG8_LDB(B0, 1, 0); PG8_SCHED; PG8_LDA(At, 1, 0); PG8_STAGE(PG8_SA(0, 1), a2 + hstepA, voffA);
            PG8_WAIT_L(8); PG8_BAR; PG8_WAIT_L(0); PG8_MMA(0, 0, At, B0); PG8_BAR; PG8_SCHED;
            PG8_LDB(B1, 1, 1); PG8_STAGE(PG8_SB(1, 0), b3, voffB);
            PG8_BAR; PG8_WAIT_L(0); PG8_MMA(0, 1, At, B1); PG8_BAR;
            PG8_LDA(At, 1, 1); PG8_STAGE(PG8_SA(1, 0), a3, voffA);
            PG8_BAR; PG8_WAIT_L(0); PG8_MMA(1, 0, At, B0); PG8_BAR; PG8_SCHED;
            PG8_STAGE(PG8_SB(1, 1), b3 + hstepB, voffB);
            PG8_WAIT_V(6); PG8_BAR; PG8_MMA(1, 1, At, B1); PG8_BAR;
            }
            if constexpr (Epi::MIDK) { if (t + 2 == (nt >> 1)) E.mid(acc, cur, wr, wc, fr, fq); }
        }
        if constexpr (ALIGN_EPI) { if (wr == 0) PG8_BAR; }
        if constexpr (!Epi::AFTER_DRAIN) { E(acc, cur, wr, wc, fr, fq); S.done(cur); }
        if (!has_next) break;
#pragma unroll
        for (int a = 0; a < 2; ++a)
#pragma unroll
            for (int b = 0; b < 2; ++b)
#pragma unroll
                for (int m = 0; m < 4; ++m)
#pragma unroll
                    for (int n = 0; n < 2; ++n) acc[a][b][m][n] = (f32x4){0.f, 0.f, 0.f, 0.f};
        cur = nxt; cA = nA; cB = nB; ++ui;
        if constexpr (ALIGN_EPI) { if (wr == 1) PG8_BAR; }
    }
    PG8_WAIT_V(0);
    if constexpr (!ALIGN_EPI) { if (wr == 0) PG8_BAR; }
    PG8_BAR;
    if constexpr (Epi::AFTER_DRAIN) { E.fused(acc, cur, wr, wc, fr, fq, lds, wid, lane); S.done(cur); }
#undef PG8_SA
#undef PG8_SB
#undef PG8_STAGE
#undef PG8_LDA
#undef PG8_LDB
#undef PG8_MMA
#undef PG8_WAIT_V
#undef PG8_WAIT_L
#undef PG8_BAR
#undef PG8_SCHED
}
}


#define LAS __attribute__((address_space(3)))
using pg8::bf16_t; using pg8::bf16x8; using pg8::f32x4; using pg8::u32x4; using pg8::Unit;
typedef float f32x16 __attribute__((ext_vector_type(16)));
typedef unsigned u32x2 __attribute__((ext_vector_type(2)));
typedef short s16x4 __attribute__((ext_vector_type(4)));
constexpr int DM = 1024, TP = 65536, TS = 16384, T = TP + TS;
constexpr int NH = 8, DQK = 96, DFF = 4096, INW = 2976;
constexpr float EPS = 1e-6f;
constexpr size_t MiB = (size_t)1 << 20;
constexpr size_t WS_SSQ = 0;
constexpr size_t WS_BAR = 5 * MiB + 832 * 1024;
constexpr size_t WS_ROPE = 950 * MiB;
constexpr size_t WS_M1A = 5 * MiB, WS_M1B = 5 * MiB + 65536, WS_M2A = 5 * MiB + 262144, WS_M2B = 6 * MiB;
constexpr size_t WS_W = 14 * MiB, W_LAYER = 28 * MiB;
constexpr size_t WO_IN1 = 0, WO_G = 3 * MiB, WO_UQ = 7 * MiB, WO_UKV = 7 * MiB + 393216, WO_OF = 8 * MiB, WO_OA = 9 * MiB, WO_OUT = 10 * MiB, WO_UP = 12 * MiB, WO_DN = 20 * MiB;
constexpr size_t WS_AB = 70 * MiB;
constexpr size_t WS_BIG = 230 * MiB;
constexpr size_t WS_VC = WS_BIG, WS_KVRAW = WS_BIG + 160 * MiB, WS_QB = WS_BIG + 320 * MiB, WS_KB = WS_BIG + 440 * MiB;
constexpr size_t WS_CQ = WS_BIG + 560 * MiB, WS_CKV = WS_BIG + 600 * MiB, WS_FA = WS_BIG + 560 * MiB;
constexpr size_t WS_GG = WS_BIG, WS_MB = WS_BIG + 320 * MiB, WS_UB = WS_BIG;
constexpr size_t WS_END = 952 * MiB;

typedef float f32x2_t __attribute__((ext_vector_type(2))); typedef __bf16 bf16x2_t __attribute__((ext_vector_type(2)));
__device__ __forceinline__ unsigned cvt_pk(float lo, float hi) { f32x2_t v = {lo, hi}; bf16x2_t b = __builtin_convertvector(v, bf16x2_t); return __builtin_bit_cast(unsigned, b); }
__device__ __forceinline__ float bf_lo(unsigned w) { return __uint_as_float(w << 16); }
__device__ __forceinline__ float bf_hi(unsigned w) { return __uint_as_float(w & 0xffff0000u); }
__device__ __forceinline__ u32x4 pack8(f32x4 a, f32x4 b) { u32x4 w; w.x = cvt_pk(a[0], a[1]); w.y = cvt_pk(a[2], a[3]); w.z = cvt_pk(b[0], b[1]); w.w = cvt_pk(b[2], b[3]); return w; }
__device__ __forceinline__ float sumsq8(f32x4 a, f32x4 b) { return (a[0] * a[0] + a[1] * a[1]) + (a[2] * a[2] + a[3] * a[3]) + (b[0] * b[0] + b[1] * b[1]) + (b[2] * b[2] + b[3] * b[3]); }
__device__ __forceinline__ void unpack8(u32x4 w, f32x4& a, f32x4& b) { a[0] = bf_lo(w.x); a[1] = bf_hi(w.x); a[2] = bf_lo(w.y); a[3] = bf_hi(w.y); b[0] = bf_lo(w.z); b[1] = bf_hi(w.z); b[2] = bf_lo(w.w); b[3] = bf_hi(w.w); }
typedef unsigned long long u64;
__device__ __forceinline__ float rs_of(u64 ssq, float inv_n) { return 1.0f / sqrtf(__ull2float_rn(ssq) * 2.3283064365386963e-10f * inv_n + EPS); }
__device__ __forceinline__ void ssq_add(u64* p, float s) { atomicAdd(p, __float2ull_rn(s * 4294967296.0f)); }

struct EpiIn {
    static constexpr bool PERM = true, AFTER_DRAIN = false, MIDK = false;
    bf16_t* Vc; bf16_t* CQ; bf16_t* CKV; const u64* ssq_x; u64* ssq_q; u64* ssq_kv; bf16_t* GG;
    __device__ __forceinline__ void operator()(const f32x4 (&acc)[2][2][4][2], const Unit& u, int wr, int wc, int fr, int fq) const {
        const int row0 = u.pm * 256 + wr * 64 + fr;
        if (u.pn >= 6) {
            const int col0 = (u.pn - 6) * 256 + wc * 32 + 8 * fq;
#pragma unroll
            for (int ai = 0; ai < 2; ++ai)
#pragma unroll
                for (int m = 0; m < 4; ++m) {
                    const int row = row0 + ai * 128 + m * 16;
                    const float rs = rs_of(ssq_x[row], 1.0f / 1024.0f);
                    bf16_t* rp = GG + (size_t)row * 2048 + col0;
#pragma unroll
                    for (int bj = 0; bj < 2; ++bj) { f32x4 v0 = acc[ai][bj][m][0] * rs, v1 = acc[ai][bj][m][1] * rs;
#pragma unroll
                        for (int e = 0; e < 4; ++e) { v0[e] = __builtin_amdgcn_rcpf(1.0f + __expf(-v0[e])); v1[e] = __builtin_amdgcn_rcpf(1.0f + __expf(-v1[e])); }
                        *(u32x4*)(rp + bj * 128) = pack8(v0, v1); }
                }
            return;
        }
        bf16_t* base; int ldc, colt; u64* ssq;
        if (u.pn < 4) { base = Vc; ldc = 1024; colt = u.pn * 256; ssq = nullptr; }
        else if (u.pn == 4) { base = CQ; ldc = 256; colt = 0; ssq = ssq_q; }
        else { base = CKV; ldc = 256; colt = 0; ssq = ssq_kv; }
        const bool only0 = (u.pn == 5);
        const int col0 = colt + wc * 32 + 8 * fq;
#pragma unroll
        for (int ai = 0; ai < 2; ++ai)
#pragma unroll
            for (int m = 0; m < 4; ++m) {
                const int row = row0 + ai * 128 + m * 16;
                const float rs = rs_of(ssq_x[row], 1.0f / 1024.0f);
                const f32x4 a0 = acc[ai][0][m][0] * rs, a1 = acc[ai][0][m][1] * rs, b0 = acc[ai][1][m][0] * rs, b1 = acc[ai][1][m][1] * rs;
                bf16_t* rp = base + (size_t)row * ldc + col0;
                *(u32x4*)(rp) = pack8(a0, a1); *(u32x4*)(rp + 128) = pack8(b0, b1);
                if (ssq) { float s = sumsq8(a0, a1); if (!only0) s += sumsq8(b0, b1);
                    s += __shfl_xor(s, 16); s += __shfl_xor(s, 32); if (fq == 0) ssq_add(ssq + row, s); }
            }
    }
};
template <int ACT, bool BLK = false> struct EpiRowScale {
    static constexpr bool PERM = true, AFTER_DRAIN = false, MIDK = false;
    bf16_t* O; int ldc; const u64* ssq; float inv_n;
    static __device__ __forceinline__ float act(float v) {
        if (ACT == 1) return __builtin_amdgcn_rcpf(1.0f + __expf(-v));
        if (ACT == 2) { const float r = fmaxf(v, 0.f); return r * r; }
        return v; }
    __device__ __forceinline__ void operator()(const f32x4 (&acc)[2][2][4][2], const Unit& u, int wr, int wc, int fr, int fq) const {
        const int row0 = u.pm * 256 + wr * 64 + fr, col0 = u.pn * 256 + wc * 32 + 8 * fq;
#pragma unroll
        for (int ai = 0; ai < 2; ++ai)
#pragma unroll
            for (int m = 0; m < 4; ++m) {
                const int row = row0 + ai * 128 + m * 16;
                const float rs = rs_of(ssq[row], inv_n);
                bf16_t* rp = BLK ? O + (((size_t)(row >> 8) * (ldc >> 6) + (col0 >> 6)) * 256 + (row & 255)) * 64 + (col0 & 63) : O + (size_t)row * ldc + col0;
#pragma unroll
                for (int bj = 0; bj < 2; ++bj) { f32x4 v0 = acc[ai][bj][m][0] * rs, v1 = acc[ai][bj][m][1] * rs;
#pragma unroll
                    for (int e = 0; e < 4; ++e) { v0[e] = act(v0[e]); v1[e] = act(v1[e]); }
                    *(u32x4*)(rp + (BLK ? bj * 2 * 256 * 64 : bj * 128)) = pack8(v0, v1); }
            }
    }
};
struct EpiMixK {
    static constexpr bool PERM = true, AFTER_DRAIN = false, MIDK = true;
    bf16_t* Mb; const bf16_t* GG;
    __device__ __forceinline__ void mid(f32x4 (&acc)[2][2][4][2], const Unit& u, int wr, int wc, int fr, int fq) const {
        const int row0 = u.pm * 256 + wr * 64 + fr, col0 = u.pn * 256 + wc * 32 + 8 * fq;
#pragma unroll
        for (int ai = 0; ai < 2; ++ai)
#pragma unroll
            for (int m = 0; m < 4; ++m) {
                const bf16_t* gp = GG + (size_t)(row0 + ai * 128 + m * 16) * 2048 + col0;
#pragma unroll
                for (int bj = 0; bj < 2; ++bj) { f32x4 f0, f1, a0, a1; unpack8(*(const u32x4*)(gp + bj * 128), f0, f1); unpack8(*(const u32x4*)(gp + 1024 + bj * 128), a0, a1);
#pragma unroll
                    for (int e = 0; e < 4; ++e) { acc[ai][bj][m][0][e] *= f0[e] * __builtin_amdgcn_rcpf(fmaxf(a0[e], 1e-30f)); acc[ai][bj][m][1][e] *= f1[e] * __builtin_amdgcn_rcpf(fmaxf(a1[e], 1e-30f)); } }
                asm volatile("" ::: "memory");
            }
    }
    __device__ __forceinline__ void operator()(const f32x4 (&acc)[2][2][4][2], const Unit& u, int wr, int wc, int fr, int fq) const {
        const int row0 = u.pm * 256 + wr * 64 + fr, col0 = u.pn * 256 + wc * 32 + 8 * fq;
#pragma unroll
        for (int ai = 0; ai < 2; ++ai)
#pragma unroll
            for (int m = 0; m < 4; ++m) {
                const int row = row0 + ai * 128 + m * 16;
                const bf16_t* gp = GG + (size_t)row * 2048 + 1024 + col0; bf16_t* mp = Mb + (((size_t)(row >> 8) * 16 + (col0 >> 6)) * 256 + (row & 255)) * 64 + (col0 & 63);
#pragma unroll
                for (int bj = 0; bj < 2; ++bj) { f32x4 a0, a1; unpack8(*(const u32x4*)(gp + bj * 128), a0, a1);
#pragma unroll
                    for (int e = 0; e < 4; ++e) { a0[e] = fmaxf(a0[e], 1e-30f); a1[e] = fmaxf(a1[e], 1e-30f); }
                    *(u32x4*)(mp + bj * 2 * 256 * 64) = pack8(acc[ai][bj][m][0] * a0, acc[ai][bj][m][1] * a1); }
                asm volatile("" ::: "memory");
            }
    }
};
template <bool RES_BF16, bool WR_AB, bool WR_F32> struct EpiResid {
    static constexpr bool PERM = true, AFTER_DRAIN = false, MIDK = false;
    const float* res0; const float* res1; float* out; bf16_t* ab; u64* ssq;
    __device__ __forceinline__ void operator()(const f32x4 (&acc)[2][2][4][2], const Unit& u, int wr, int wc, int fr, int fq) const {
        const int row0 = u.pm * 256 + wr * 64 + fr, col0 = u.pn * 256 + wc * 32 + 8 * fq;
        const float* rbase = (u.pm * 256 < TP) ? res0 : (res1 - (size_t)TP * 1024);
#pragma unroll
        for (int ai = 0; ai < 2; ++ai)
#pragma unroll
            for (int m = 0; m < 4; ++m) {
                const int row = row0 + ai * 128 + m * 16;
                const size_t off = (size_t)row * 1024 + col0;
                float s = 0.f;
#pragma unroll
                for (int bj = 0; bj < 2; ++bj) {
                    f32x4 r0, r1;
                    if (RES_BF16) unpack8(*(const u32x4*)(ab + off + bj * 128), r0, r1);
                    else { r0 = *(const f32x4*)(rbase + off + bj * 128); r1 = *(const f32x4*)(rbase + off + bj * 128 + 4); }
                    const f32x4 v0 = r0 + acc[ai][bj][m][0], v1 = r1 + acc[ai][bj][m][1];
                    if (WR_F32) { *(f32x4*)(out + off + bj * 128) = v0; *(f32x4*)(out + off + bj * 128 + 4) = v1; }
                    if (WR_AB) { *(u32x4*)(ab + off + bj * 128) = pack8(v0, v1); s += sumsq8(v0, v1); } }
                if (WR_AB) { if (ssq) { s += __shfl_xor(s, 16); s += __shfl_xor(s, 32); if (fq == 0) ssq_add(ssq + row, s); } }
                asm volatile("" ::: "memory");
            }
    }
};
struct Args { const float* in[16]; float* out; unsigned char* ws; int ph_lo, ph_hi; };
__device__ __forceinline__ float wave_sum(float v) {
#pragma unroll
    for (int o = 1; o < 64; o <<= 1) v += __shfl_xor(v, o);
    return v;
}
#define LDS_WAIT() asm volatile("s_waitcnt lgkmcnt(0)" ::: "memory")

__device__ __forceinline__ void tr_item(const float* __restrict__ W, int ldw, int col0, int K, const float* __restrict__ gain, bf16_t* __restrict__ WT, int ldt, int kofs, int row0, int nblk, LAS float* scr, int item, int lane) {
    const int kb = item / nblk, nb = item % nblk, k0 = 64 * kb, n0 = 32 * nb;
#pragma unroll 8
    for (int i = 0; i < 32; ++i) { const int kk = 2 * i + (lane >> 5); const float g = gain ? gain[k0 + kk] : 1.0f;
        scr[kk * 33 + (lane & 31)] = W[(size_t)(k0 + kk) * ldw + col0 + n0 + (lane & 31)] * g; }
    LDS_WAIT(); asm volatile("" ::: "memory");
    const int c = lane & 7;
#pragma unroll
    for (int j = 0; j < 4; ++j) { const int n = (lane >> 3) + 8 * j; const LAS float* s = scr + (8 * c) * 33 + n;
        u32x4 o; o.x = cvt_pk(s[0 * 33], s[1 * 33]); o.y = cvt_pk(s[2 * 33], s[3 * 33]); o.z = cvt_pk(s[4 * 33], s[5 * 33]); o.w = cvt_pk(s[6 * 33], s[7 * 33]);
        *(u32x4*)(WT + (size_t)(row0 + n0 + n) * ldt + kofs + k0 + 8 * c) = o; }
    LDS_WAIT(); asm volatile("" ::: "memory");
}
__device__ __forceinline__ void tr_piece(const float* W, int ldw, int col0, int ncols, int K, const float* gain, bf16_t* WT, int row0, LAS float* scr, int gw, int NGW, int lane, int ldt = 0, int kofs = 0) {
    const int nblk = ncols / 32, nitems = (K / 64) * nblk;
    for (int it = gw; it < nitems; it += NGW) tr_item(W, ldw, col0, K, gain, WT, ldt ? ldt : K, kofs, row0, nblk, scr, it, lane);
}

__device__ __forceinline__ void p0_prologue(const Args& a, unsigned char* lds_g, const int wv) {
    LAS unsigned char* lds = (LAS unsigned char*)lds_g;
    const int tid = ltid(wv), lane = tid & 63, wave = tid >> 6, G = lgdim();
    const int gw = lbid() * 8 + wave, NGW = G * 8, gt = lbid() * 512 + tid, NGT = G * 512;
    unsigned char* ws = a.ws;
    u64* ssq = (u64*)(ws + WS_SSQ);
    for (int i = gt + T; i < 8 * T; i += NGT) ssq[i] = 0ull;
    bf16_t* AB = (bf16_t*)(ws + WS_AB);
    for (int m = gw; m < T; m += NGW) {
        const float* xr = (m < TP) ? a.in[0] + (size_t)m * DM : a.in[1] + (size_t)(m - TP) * DM;
        f32x4 v[4]; float s = 0.f;
#pragma unroll
        for (int j = 0; j < 4; ++j) { v[j] = ((const f32x4*)xr)[lane + 64 * j]; s += (v[j][0] * v[j][0] + v[j][1] * v[j][1]) + (v[j][2] * v[j][2] + v[j][3] * v[j][3]); }
        s = wave_sum(s);
        u32x2* o8 = (u32x2*)(AB + (size_t)m * DM);
#pragma unroll
        for (int j = 0; j < 4; ++j) { u32x2 w; w.x = cvt_pk(v[j][0], v[j][1]); w.y = cvt_pk(v[j][2], v[j][3]); o8[lane + 64 * j] = w; }
        if (lane == 0) ssq[m] = __float2ull_rn(s * 4294967296.0f);
    }
    LAS float* scr = (LAS float*)(lds + wave * 16384);
    for (int l = 0; l < 2; ++l) {
        unsigned char* wl = ws + WS_W + (size_t)l * W_LAYER;
        const float* w_in = a.in[3] + (size_t)l * DM * INW; const float* g1 = a.in[2] + l * DM;
        tr_piece(w_in, INW, 512, 256, DM, g1, (bf16_t*)(wl + WO_IN1), 1024, scr, gw, NGW, lane);
        tr_piece(w_in, INW, 768, 160, DM, g1, (bf16_t*)(wl + WO_IN1), 1280, scr, gw, NGW, lane);
        tr_piece(w_in, INW, 928, 2048, DM, g1, (bf16_t*)(wl + WO_G), 0, scr, gw, NGW, lane);
        tr_piece(a.in[5] + (size_t)l * 256 * 768, 768, 0, 768, 256, a.in[4] + l * 256, (bf16_t*)(wl + WO_UQ), 0, scr, gw, NGW, lane);
        tr_piece(a.in[7] + (size_t)l * 128 * 1024, 1024, 0, 1024, 128, a.in[6] + l * 128, (bf16_t*)(wl + WO_UKV), 0, scr, gw, NGW, lane);
        tr_piece(a.in[10] + (size_t)l * 512 * 1024, 1024, 0, 1024, 512, nullptr, (bf16_t*)(wl + WO_OF), 0, scr, gw, NGW, lane, 1024, 0);
        tr_piece(a.in[11] + (size_t)l * 512 * 1024, 1024, 0, 1024, 512, nullptr, (bf16_t*)(wl + WO_OF), 0, scr, gw, NGW, lane, 1024, 512);
        tr_piece(a.in[12] + (size_t)l * 1024 * 1024, 1024, 0, 1024, 1024, nullptr, (bf16_t*)(wl + WO_OUT), 0, scr, gw, NGW, lane);
        tr_piece(a.in[14] + (size_t)l * 1024 * 4096, 4096, 0, 4096, 1024, a.in[13] + l * DM, (bf16_t*)(wl + WO_UP), 0, scr, gw, NGW, lane);
        tr_piece(a.in[15] + (size_t)l * 4096 * 1024, 1024, 0, 1024, 4096, nullptr, (bf16_t*)(wl + WO_DN), 0, scr, gw, NGW, lane);
        u32x4* z = (u32x4*)((bf16_t*)(wl + WO_IN1) + (size_t)1440 * DM);
        for (int i = gt; i < 96 * DM / 8; i += NGT) z[i] = (u32x4){0u, 0u, 0u, 0u};
    }
    {
        bf16_t* m1a = (bf16_t*)(ws + WS_M1A); bf16_t* m1b = (bf16_t*)(ws + WS_M1B); bf16_t* m2a = (bf16_t*)(ws + WS_M2A); bf16_t* m2b = (bf16_t*)(ws + WS_M2B);
        for (int i = gt; i < 64 * 64 + 256 * 256; i += NGT) {
            const bool big = i >= 64 * 64; const int j = big ? i - 64 * 64 : i; const int N1 = big ? 128 : 32, W2 = 2 * N1;
            const int r = j / W2, c = j % W2, pp = r / N1, k1 = r % N1, p = c / N1, n1 = c % N1;
            const float ang = 2.0f * (float)((n1 * k1) % N1) / (float)N1; const float cs = cospif(ang), sn = sinpif(ang);
            const float sc = big ? 0.0078125f : 0.02209708691207961f;
            const float v = (pp == p) ? cs : (pp == 0 ? sn : -sn);
            (big ? m1b : m1a)[j] = (bf16_t)(cvt_pk(v * sc, 0.f) & 0xffffu);
        }
        for (int i = gt; i < 32 * 64 * 128 + 128 * 128 * 256; i += NGT) {
            const bool big = i >= 32 * 64 * 128; const int j = big ? i - 32 * 64 * 128 : i;
            const int N1 = big ? 128 : 32, N2 = big ? 128 : 64, S = N1 * N2, W2 = 2 * N2;
            const int c = j % W2, k2 = (j / W2) % N2, k1 = j / (W2 * N2), p = c / N2, n2 = c % N2;
            const int mm = (n2 * (k1 + N1 * k2)) % S; const float ang = 2.0f * (float)mm / (float)S;
            const float v = p ? sinpif(ang) : cospif(ang);
            (big ? m2b : m2a)[j] = (bf16_t)(cvt_pk(v, 0.f) & 0xffffu);
        }
        float2* rt = (float2*)(ws + WS_ROPE);
        for (int i = gt; i < 16384 * 16; i += NGT) { const int pos = i >> 4, f = i & 15;
            const float inv = powf(10000.0f, -(float)(2 * f) / 32.0f); const float ang = (float)pos * inv; float s, c; sincosf(ang, &s, &c); rt[i] = make_float2(c, s); }
    }
    __syncthreads();
    {
        LAS float* cs = (LAS float*)lds; LAS float* sn = cs + 128; LAS float* wl_s = sn + 128;
        if (tid < 128) { cs[tid] = cospif(2.0f * (float)tid / 128.0f); sn[tid] = sinpif(2.0f * (float)tid / 128.0f); }
        for (int it = lbid(); it < 2 * 128 * 4; it += G) {
            const int l = it >> 9, db = (it >> 2) & 127, g = it & 3, d0 = db * 8;
            const float* w_in = a.in[3] + (size_t)l * DM * INW; const float* g1 = a.in[2] + l * DM;
            __syncthreads();
            for (int i = tid; i < 1024; i += 512) wl_s[i] = w_in[(size_t)(d0 + (i >> 7)) * INW + g * 128 + (i & 127)];
            __syncthreads();
            const int j = tid & 127, p = (tid >> 7) & 1, dh = tid >> 8;
            float acc0 = 0.f, acc1 = 0.f, acc2 = 0.f, acc3 = 0.f;
            for (int c = 0; c < 128; ++c) { const int idx = (c * j) & 127; const float w = p ? -sn[idx] : cs[idx];
                acc0 += wl_s[(dh * 4 + 0) * 128 + c] * w; acc1 += wl_s[(dh * 4 + 1) * 128 + c] * w; acc2 += wl_s[(dh * 4 + 2) * 128 + c] * w; acc3 += wl_s[(dh * 4 + 3) * 128 + c] * w; }
            const float sc = 0.08838834764831845f; const int dd = d0 + dh * 4;
            u32x2 o; o.x = cvt_pk(acc0 * sc * g1[dd], acc1 * sc * g1[dd + 1]); o.y = cvt_pk(acc2 * sc * g1[dd + 2], acc3 * sc * g1[dd + 3]);
            bf16_t* dst = (bf16_t*)(ws + WS_W + (size_t)l * W_LAYER + WO_IN1) + (size_t)(p * 512 + g * 128 + j) * DM + dd;
            *(u32x2*)dst = o;
        }
        __syncthreads();
    }
}

template <bool WHICH> __device__ __forceinline__ const bf16_t* fin_src(const bf16_t* Qb, const bf16_t* KV, const bf16_t* CKV, int token, int h, int pc) {
    return !WHICH ? Qb + (size_t)token * 768 + h * 96 + pc * 32 : (pc < 2 ? KV + (size_t)token * 1024 + h * 128 + pc * 32 : CKV + (size_t)token * 256 + 128);
}
__device__ __forceinline__ void fin_math(const u32x4 (&w)[4], const float (&g)[32], const float2* __restrict__ rt, int token, int part, u32x4 (&o)[4]) {
    float v[32];
#pragma unroll
    for (int j = 0; j < 4; ++j) { v[8*j] = bf_lo(w[j].x); v[8*j+1] = bf_hi(w[j].x); v[8*j+2] = bf_lo(w[j].y); v[8*j+3] = bf_hi(w[j].y); v[8*j+4] = bf_lo(w[j].z); v[8*j+5] = bf_hi(w[j].z); v[8*j+6] = bf_lo(w[j].w); v[8*j+7] = bf_hi(w[j].w); }
    float ss = 0.f;
#pragma unroll
    for (int d = 0; d < 32; ++d) ss += v[d] * v[d];
    if (part == 3) ss = 0.f;
    ss += __shfl_xor(ss, 1); ss += __shfl_xor(ss, 2);
    const float r = 1.0f / sqrtf(ss * (1.0f / 96.0f) + EPS);
#pragma unroll
    for (int d = 0; d < 32; ++d) v[d] = v[d] * r * g[d];
    if (part == 2) { const int pos = token < TP ? (token & 2047) : token - TP;
#pragma unroll
        for (int f = 0; f < 16; ++f) { const float2 cs = rt[pos * 16 + f]; const float x1 = v[f], x2 = v[16 + f]; v[f] = x1 * cs.x - x2 * cs.y; v[16 + f] = x2 * cs.x + x1 * cs.y; } }
#pragma unroll
    for (int j = 0; j < 4; ++j) { o[j].x = cvt_pk(v[8*j], v[8*j+1]); o[j].y = cvt_pk(v[8*j+2], v[8*j+3]); o[j].z = cvt_pk(v[8*j+4], v[8*j+5]); o[j].w = cvt_pk(v[8*j+6], v[8*j+7]); }
}
template <bool WHICH> __device__ __forceinline__ void finalize_pass(const Args& a, int l, const int wv) {
    unsigned char* ws = a.ws;
    bf16_t* Qb = (bf16_t*)(ws + WS_QB); bf16_t* Kb = (bf16_t*)(ws + WS_KB); const bf16_t* KV = (const bf16_t*)(ws + WS_KVRAW); const bf16_t* CKV = (const bf16_t*)(ws + WS_CKV);
    const float2* rt = (const float2*)(ws + WS_ROPE);
    const int NGT = lgdim() * 512, gt = lbid() * 512 + ltid(wv), part = gt & 3, pc = part < 3 ? part : 2;
    static_assert((T * NH * 4) % (2 * 256 * 512) == 0, "uniform trip count");
    float g[32];
    { const float* gg = (WHICH ? a.in[9] : a.in[8]) + l * DQK + pc * 32;
#pragma unroll
      for (int d = 0; d < 32; ++d) g[d] = WHICH ? gg[d] : gg[d] * 0.14724448646421766f; }
    bf16_t* dst = WHICH ? Kb : Qb;
    for (int i = gt; i < T * NH * 4; i += 2 * NGT) {
        const int t0 = (i >> 2) >> 3, h0 = (i >> 2) & 7, i1 = i + NGT, t1 = (i1 >> 2) >> 3, h1 = (i1 >> 2) & 7;
        const u32x4* s0 = (const u32x4*)fin_src<WHICH>(Qb, KV, CKV, t0, h0, pc); const u32x4* s1 = (const u32x4*)fin_src<WHICH>(Qb, KV, CKV, t1, h1, pc);
        u32x4 w0[4], w1[4], o0[4], o1[4];
#pragma unroll
        for (int j = 0; j < 4; ++j) { w0[j] = s0[j]; w1[j] = s1[j]; }
        fin_math(w0, g, rt, t0, part, o0); fin_math(w1, g, rt, t1, part, o1);
        if (part < 3) { u32x4* d0 = (u32x4*)(dst + (size_t)t0 * 768 + h0 * 96 + part * 32); u32x4* d1 = (u32x4*)(dst + (size_t)t1 * 768 + h1 * 96 + part * 32);
#pragma unroll
            for (int j = 0; j < 4; ++j) { d0[j] = o0[j]; d1[j] = o1[j]; } }
    }
}
__device__ __forceinline__ void finalize_qk(const Args& a, int l, const int wv) { finalize_pass<true>(a, l, wv); }

__device__ __forceinline__ int crow(int r, int hi) { return (r & 3) + 8 * (r >> 2) + 4 * hi; }
typedef short v4i16_t __attribute__((ext_vector_type(4)));
__device__ __forceinline__ s16x4 vtr(const LAS char* p) { return __builtin_bit_cast(s16x4, __builtin_amdgcn_ds_read_tr16_b64_v4i16((LAS v4i16_t*)p)); }
template <int KC> __device__ __forceinline__ void seqmix_load(u32x4 (&st)[KC / 32], const bf16_t* in, size_t in_stride, int tid) {
    constexpr int KH = KC / 2;
#pragma unroll
    for (int i = 0; i < KC / 32; ++i) { const int id = tid + 512 * i, row = id >> 4, ch = id & 15, p = row / KH, n = row % KH;
        st[i] = *(const u32x4*)(in + (size_t)n * in_stride + p * 512 + ch * 8); }
}
template <int MOUT, int KC, int MH, int ISTR, int OSTR, class Desc>
__device__ __forceinline__ void seqmix_run(unsigned char* lds_g, const Desc D, int first, int step, int nunits, const int wv) {
    constexpr size_t in_stride = ISTR, out_stride = OSTR;
    constexpr int PITCH = 320, NLD = KC / 32, NRB = MOUT / 32, WR = NRB < 8 ? NRB : 8, WCN = 8 / WR, CPW = 4 / WCN, NKS = KC / 16;
    LAS char* lds = (LAS char*)lds_g;
    const int tid = ltid(wv), lane = tid & 63, wid = tid >> 6, r32 = lane & 31, hi = lane >> 5;
    const int rb = wid % WR, cg0 = (wid / WR) * CPW;
    const LAS char* vb = lds + (8 * hi + ((lane >> 2) & 3)) * PITCH + (16 * ((lane >> 4) & 1) + 4 * (lane & 3)) * 2;
    u32x4 st[NLD];
    int u = first;
    if (u < nunits) { const bf16_t* mat; const bf16_t* in; bf16_t* out; D(u, mat, in, out); seqmix_load<KC>(st, in, in_stride, tid); }
    while (u < nunits) {
        const bf16_t* mat; const bf16_t* in; bf16_t* out; D(u, mat, in, out);
        bf16x8 af[NKS];
#pragma unroll
        for (int ks = 0; ks < NKS; ++ks) af[ks] = *(const bf16x8*)(mat + (size_t)(rb * 32 + r32) * KC + ks * 16 + hi * 8);
        __syncthreads();
#pragma unroll
        for (int i = 0; i < NLD; ++i) { const int id = tid + 512 * i, row = id >> 4, ch = id & 15; *(LAS u32x4*)(lds + row * PITCH + ch * 16) = st[i]; }
        __syncthreads();
        const int un = u + step;
        if (un < nunits) { const bf16_t* m2; const bf16_t* in2; bf16_t* o2; D(un, m2, in2, o2); seqmix_load<KC>(st, in2, in_stride, tid); }
        f32x16 acc[CPW];
#pragma unroll
        for (int c = 0; c < CPW; ++c) acc[c] = (f32x16){};
#pragma unroll
        for (int ks = 0; ks < NKS; ++ks)
#pragma unroll
            for (int c = 0; c < CPW; ++c) {
                const s16x4 lo = vtr(vb + ks * 16 * PITCH + (cg0 + c) * 64), h4 = vtr(vb + ks * 16 * PITCH + 4 * PITCH + (cg0 + c) * 64);
                const bf16x8 b = (bf16x8){lo[0], lo[1], lo[2], lo[3], h4[0], h4[1], h4[2], h4[3]};
                acc[c] = __builtin_amdgcn_mfma_f32_32x32x16_bf16(af[ks], b, acc[c], 0, 0, 0);
            }
        { bf16_t* ob = out + (size_t)(((rb * 32) % MH) + 4 * hi) * out_stride + ((rb * 32) / MH) * 512 + cg0 * 32 + r32;
#pragma unroll
          for (int c = 0; c < CPW; ++c)
#pragma unroll
            for (int r = 0; r < 16; ++r) ob[(size_t)((r & 3) + 8 * (r >> 2)) * out_stride + c * 32] = (bf16_t)(cvt_pk(acc[c][r], 0.f) & 0xffffu); }
        u = un;
    }
    __syncthreads();
}
struct DescS1S { bf16_t* VC; const bf16_t* m; __device__ __forceinline__ void operator()(int u, const bf16_t*& mat, const bf16_t*& in, bf16_t*& out) const {
    const int chunk = u & 3, n2 = u >> 2; bf16_t* p = VC + (size_t)(TP + n2) * 1024 + chunk * 128; mat = m; in = p; out = p; } };
struct DescS1P { bf16_t* VC; const bf16_t* m; __device__ __forceinline__ void operator()(int u, const bf16_t*& mat, const bf16_t*& in, bf16_t*& out) const {
    const int chunk = u & 3, n2 = (u >> 2) & 63, b = u >> 8; bf16_t* p = VC + (size_t)(b * 2048 + n2) * 1024 + chunk * 128; mat = m; in = p; out = p; } };
struct DescS2S { const bf16_t* T1; bf16_t* FA; const bf16_t* m; __device__ __forceinline__ void operator()(int u, const bf16_t*& mat, const bf16_t*& in, bf16_t*& out) const {
    const int chunk = u & 3, k1 = u >> 2; mat = m + (size_t)k1 * 128 * 256; in = T1 + (size_t)(TP + 128 * k1) * 1024 + chunk * 128; out = FA + (size_t)(TP + k1) * 1024 + chunk * 128; } };
struct DescS2P { const bf16_t* T1; bf16_t* FA; const bf16_t* m; __device__ __forceinline__ void operator()(int u, const bf16_t*& mat, const bf16_t*& in, bf16_t*& out) const {
    const int chunk = u & 3, k1 = (u >> 2) & 31, b = u >> 7; mat = m + (size_t)k1 * 64 * 128; in = T1 + (size_t)(b * 2048 + 64 * k1) * 1024 + chunk * 128; out = FA + (size_t)(b * 2048 + k1) * 1024 + chunk * 128; } };
__device__ __forceinline__ void fourier_stage1(const Args& a, unsigned char* lds, const int wv) {
    unsigned char* ws = a.ws; bf16_t* VC = (bf16_t*)(ws + WS_VC);
    seqmix_run<256, 256, 128, 128 * 1024, 128 * 1024>(lds, DescS1S{VC, (const bf16_t*)(ws + WS_M1B)}, lbid(), lgdim(), 512, wv);
    seqmix_run<64, 64, 32, 64 * 1024, 64 * 1024>(lds, DescS1P{VC, (const bf16_t*)(ws + WS_M1A)}, lbid(), lgdim(), 8192, wv);
}
__device__ __forceinline__ void fourier_stage2(const Args& a, unsigned char* lds, const int wv) {
    unsigned char* ws = a.ws; const bf16_t* T1 = (const bf16_t*)(ws + WS_VC); bf16_t* FA = (bf16_t*)(ws + WS_FA);
    seqmix_run<128, 256, 128, 1024, 128 * 1024>(lds, DescS2S{T1, FA, (const bf16_t*)(ws + WS_M2B)}, lbid(), lgdim(), 512, wv);
    seqmix_run<64, 128, 64, 1024, 32 * 1024>(lds, DescS2P{T1, FA, (const bf16_t*)(ws + WS_M2A)}, lbid(), lgdim(), 4096, wv);
}

namespace att {
constexpr int NW = 8, QBLK = 32, KVBLK = 64;
constexpr int LDQ = 768, LDK = 768, LDV = 1024, LDO = 1024;
constexpr float SCALE = 0.10206207261596575f;
constexpr float THR = 8.f;
constexpr size_t SHM_V = 64 * 128 * 2, SHM_K = 64 * 256;
#define KSWZ(row, colB) ((row) * 256 + ((colB) ^ (((row) & 7) << 4)))
#define SBAR() __builtin_amdgcn_sched_barrier(0)
#define MX3(a, b, c) __builtin_fmaxf(__builtin_fmaxf((a), (b)), (c))
template <bool FIRST> __device__ __forceinline__ void partialSM(f32x16& p0, f32x16& p1, float& m_reg, f32x16& negm, float& alpha) {
  constexpr float THR2 = THR * 1.4426950408889634f;
  float a = MX3(p0[0], p0[1], p1[0]), b = MX3(p0[2], p0[3], p1[1]); a = MX3(a, p1[2], p1[3]);
#pragma unroll
  for (int r = 4; r < 16; r += 4) { a = MX3(a, p0[r], p0[r + 1]); b = MX3(b, p0[r + 2], p0[r + 3]); a = MX3(a, p1[r], p1[r + 1]); b = MX3(b, p1[r + 2], p1[r + 3]); }
  float pmax = __builtin_fmaxf(a, b);
  { auto rr = __builtin_amdgcn_permlane32_swap(__float_as_uint(pmax), __float_as_uint(pmax), false, false);
    pmax = __builtin_fmaxf(__uint_as_float(rr[0]), __uint_as_float(rr[1])); }
  alpha = 1.f;
  if (FIRST || !__builtin_expect(__all(pmax <= THR2), 1)) {
    const float dl = FIRST ? pmax : __builtin_fmaxf(pmax, 0.f);
    m_reg += dl;
#pragma unroll
    for (int r = 0; r < 16; ++r) { p0[r] -= dl; p1[r] -= dl; }
#pragma unroll
    for (int r = 0; r < 16; ++r) negm[r] = -m_reg;
    if (!FIRST) alpha = __builtin_amdgcn_exp2f(-dl);
  }
#pragma unroll
  for (int r = 0; r < 16; ++r) p0[r] = __builtin_amdgcn_exp2f(p0[r]);
}
__device__ __forceinline__ void finishSM(f32x16& p0, f32x16& p1, float alpha, float& l_reg, bf16x8& pa0, bf16x8& pa1, bf16x8& pa2, bf16x8& pa3) {
#pragma unroll
  for (int r = 0; r < 16; ++r) p1[r] = __builtin_amdgcn_exp2f(p1[r]);
  float ps = 0;
#pragma unroll
  for (int r = 0; r < 16; ++r) ps += p0[r];
#pragma unroll
  for (int r = 0; r < 16; ++r) ps += p1[r];
  { auto rr = __builtin_amdgcn_permlane32_swap(__float_as_uint(ps), __float_as_uint(ps), false, false);
    ps = __uint_as_float(rr[0]) + __uint_as_float(rr[1]); }
  l_reg = l_reg * alpha + ps;
#define PK4(P, BASE, OUT) do { unsigned a0 = cvt_pk(P[BASE + 0], P[BASE + 1]), a1 = cvt_pk(P[BASE + 2], P[BASE + 3]);   \
    unsigned b0 = cvt_pk(P[BASE + 4], P[BASE + 5]), b1 = cvt_pk(P[BASE + 6], P[BASE + 7]);                              \
    auto r0 = __builtin_amdgcn_permlane32_swap(a0, b0, false, false); auto r1 = __builtin_amdgcn_permlane32_swap(a1, b1, false, false); \
    u32x4 w = {r0[0], r1[0], r0[1], r1[1]}; OUT = *reinterpret_cast<bf16x8*>(&w); } while (0)
  PK4(p0, 0, pa0); PK4(p0, 8, pa1); PK4(p1, 0, pa2); PK4(p1, 8, pa3);
#undef PK4
}
__device__ __forceinline__ void qkt(f32x16& p0, f32x16& p1, const char* Ks, const bf16x8* qr, const f32x16& negm, int r32, int hi) {
#pragma unroll
  for (int d0 = 0; d0 < 6; ++d0) { int cb = (d0 * 16 + hi * 8) * 2;
    bf16x8 b0 = *reinterpret_cast<const bf16x8*>(Ks + KSWZ(r32, cb));
    bf16x8 b1 = *reinterpret_cast<const bf16x8*>(Ks + KSWZ(32 + r32, cb));
    p0 = __builtin_amdgcn_mfma_f32_32x32x16_bf16(b0, qr[d0], d0 == 0 ? negm : p0, 0, 0, 0);
    p1 = __builtin_amdgcn_mfma_f32_32x32x16_bf16(b1, qr[d0], d0 == 0 ? negm : p1, 0, 0, 0); }
}
__device__ __forceinline__ int v_st(int k, int c) { const int kk = (k & ~0xC) | ((k & 4) << 1) | ((k & 8) >> 1); return ((kk >> 3) * 4 + (c >> 5)) * 512 + ((kk & 7) * 32 + (c & 31)) * 2; }
__device__ __forceinline__ int v_rd_base(int lane) { return ((lane & 3) << 3) | (((lane >> 2) & 3) << 6) | (((lane >> 4) & 1) << 5) | (((lane >> 5) & 1) << 8); }
constexpr int v_rd_off(int d0, int ks, int half) { return d0 * 512 + ks * 4096 + half * 2048; }
template <int OFF> __device__ __forceinline__ s16x4 tr_read(int vb) {
  s16x4 r; asm volatile("ds_read_b64_tr_b16 %0, %1 offset:%2" : "=&v"(r) : "v"(vb), "i"(OFF) : "memory"); return r;
}
template <int D0> __device__ __forceinline__ void pv_one(f32x16& od, int vb, bf16x8 pa0, bf16x8 pa1, bf16x8 pa2, bf16x8 pa3) {
  const s16x4 l0 = tr_read<v_rd_off(D0, 0, 0)>(vb), h0 = tr_read<v_rd_off(D0, 0, 1)>(vb), l1 = tr_read<v_rd_off(D0, 1, 0)>(vb), h1 = tr_read<v_rd_off(D0, 1, 1)>(vb);
  const s16x4 l2 = tr_read<v_rd_off(D0, 2, 0)>(vb), h2 = tr_read<v_rd_off(D0, 2, 1)>(vb), l3 = tr_read<v_rd_off(D0, 3, 0)>(vb), h3 = tr_read<v_rd_off(D0, 3, 1)>(vb);
  asm volatile("s_waitcnt lgkmcnt(0)" ::: "memory"); SBAR();
#define PK(L, H) (bf16x8){L[0], L[1], L[2], L[3], H[0], H[1], H[2], H[3]}
  od = __builtin_amdgcn_mfma_f32_32x32x16_bf16(pa0, PK(l0, h0), od, 0, 0, 0);
  od = __builtin_amdgcn_mfma_f32_32x32x16_bf16(pa1, PK(l1, h1), od, 0, 0, 0);
  od = __builtin_amdgcn_mfma_f32_32x32x16_bf16(pa2, PK(l2, h2), od, 0, 0, 0);
  od = __builtin_amdgcn_mfma_f32_32x32x16_bf16(pa3, PK(l3, h3), od, 0, 0, 0);
#undef PK
}
__device__ __forceinline__ void pv_d0(f32x16* o, int vb, bf16x8 pa0, bf16x8 pa1, bf16x8 pa2, bf16x8 pa3) {
  pv_one<0>(o[0], vb, pa0, pa1, pa2, pa3); pv_one<1>(o[1], vb, pa0, pa1, pa2, pa3);
}
__device__ __forceinline__ void glds16(const void* gsrc, unsigned lds_dst) { unsigned keep;
  asm volatile("s_mov_b32 %0, m0\n\ts_mov_b32 m0, %2\n\ts_nop 0\n\tglobal_load_lds_dwordx4 %1, off\n\ts_mov_b32 m0, %0" : "=&s"(keep) : "v"(gsrc), "s"(lds_dst) : "memory"); }
#define WAIT_BAR(N) asm volatile("s_waitcnt vmcnt(" #N ") lgkmcnt(0)\n\ts_barrier" ::: "memory")
constexpr int KSLOT = 16384, VSLOT = 8192, LDS_KR = 0, LDS_VR = 4 * KSLOT, LDS_WSF = LDS_VR + 4 * VSLOT;
constexpr int v_rd_off2(int d0, int ks, int half) { return d0 * 512 + ks * 2048 + half * 1024; }
__device__ __forceinline__ void pv2(f32x16* o, int vb, bf16x8 pa0, bf16x8 pa1, bf16x8 pa2, bf16x8 pa3) {
  const s16x4 a0 = tr_read<v_rd_off2(0, 0, 0)>(vb), b0 = tr_read<v_rd_off2(0, 0, 1)>(vb), c0 = tr_read<v_rd_off2(1, 0, 0)>(vb), d0 = tr_read<v_rd_off2(1, 0, 1)>(vb);
  const s16x4 a1 = tr_read<v_rd_off2(0, 1, 0)>(vb), b1 = tr_read<v_rd_off2(0, 1, 1)>(vb), c1 = tr_read<v_rd_off2(1, 1, 0)>(vb), d1 = tr_read<v_rd_off2(1, 1, 1)>(vb);
  const s16x4 a2 = tr_read<v_rd_off2(0, 2, 0)>(vb), b2 = tr_read<v_rd_off2(0, 2, 1)>(vb), c2 = tr_read<v_rd_off2(1, 2, 0)>(vb), d2 = tr_read<v_rd_off2(1, 2, 1)>(vb);
  const s16x4 a3 = tr_read<v_rd_off2(0, 3, 0)>(vb), b3 = tr_read<v_rd_off2(0, 3, 1)>(vb), c3 = tr_read<v_rd_off2(1, 3, 0)>(vb), d3 = tr_read<v_rd_off2(1, 3, 1)>(vb);
  asm volatile("s_waitcnt lgkmcnt(0)" ::: "memory"); SBAR();
#define PK(L, H) (bf16x8){L[0], L[1], L[2], L[3], H[0], H[1], H[2], H[3]}
  o[0] = __builtin_amdgcn_mfma_f32_32x32x16_bf16(pa0, PK(a0, b0), o[0], 0, 0, 0);
  o[1] = __builtin_amdgcn_mfma_f32_32x32x16_bf16(pa0, PK(c0, d0), o[1], 0, 0, 0);
  o[0] = __builtin_amdgcn_mfma_f32_32x32x16_bf16(pa1, PK(a1, b1), o[0], 0, 0, 0);
  o[1] = __builtin_amdgcn_mfma_f32_32x32x16_bf16(pa1, PK(c1, d1), o[1], 0, 0, 0);
  o[0] = __builtin_amdgcn_mfma_f32_32x32x16_bf16(pa2, PK(a2, b2), o[0], 0, 0, 0);
  o[1] = __builtin_amdgcn_mfma_f32_32x32x16_bf16(pa2, PK(c2, d2), o[1], 0, 0, 0);
  o[0] = __builtin_amdgcn_mfma_f32_32x32x16_bf16(pa3, PK(a3, b3), o[0], 0, 0, 0);
  o[1] = __builtin_amdgcn_mfma_f32_32x32x16_bf16(pa3, PK(c3, d3), o[1], 0, 0, 0);
#undef PK
}
__device__ __forceinline__ void attn_unit(const bf16_t* __restrict__ Qb, const bf16_t* __restrict__ Kh, const bf16_t* __restrict__ Vh, bf16_t* __restrict__ Ob, int seq, char* lds, const int wv, const float* __restrict__ gq, const float2* __restrict__ rt, int pos0) {
  const int tid = ltid(wv), wid = wv, lane = tid & 63, r32 = lane & 31, hi = lane >> 5;
  const unsigned lds0 = (unsigned)(uintptr_t)lds;
  float* ws = (float*)(lds + LDS_WSF) + wid * 64; float* li_l = ws; float* al_l = ws + 32;
  float m_reg = 0.f, l_reg = 0; f32x16 o[2] = {}; f32x16 negm = {}; bf16x8 qr[6];
  const bf16_t* Qw = Qb + (long)(wid * QBLK + r32) * LDQ + hi * 8;
  __syncthreads();
  {
    float v[6][8]; float ss = 0.f;
#pragma unroll
    for (int d0 = 0; d0 < 6; ++d0) { const u32x4 w = *reinterpret_cast<const u32x4*>(Qw + d0 * 16);
      v[d0][0] = bf_lo(w.x); v[d0][1] = bf_hi(w.x); v[d0][2] = bf_lo(w.y); v[d0][3] = bf_hi(w.y); v[d0][4] = bf_lo(w.z); v[d0][5] = bf_hi(w.z); v[d0][6] = bf_lo(w.w); v[d0][7] = bf_hi(w.w);
#pragma unroll
      for (int j = 0; j < 8; ++j) ss += v[d0][j] * v[d0][j]; }
    ss += __shfl_xor(ss, 32);
    const float r = (1.0f / sqrtf(ss * (1.0f / 96.0f) + EPS));
#pragma unroll
    for (int d0 = 0; d0 < 6; ++d0)
#pragma unroll
      for (int j = 0; j < 8; ++j) v[d0][j] = v[d0][j] * r * gq[d0 * 16 + hi * 8 + j];
    const int pos = pos0 + wid * QBLK + r32;
#pragma unroll
    for (int j = 0; j < 8; ++j) { const float2 cs = rt[pos * 16 + hi * 8 + j]; const float x1 = v[4][j], x2 = v[5][j]; v[4][j] = x1 * cs.x - x2 * cs.y; v[5][j] = x2 * cs.x + x1 * cs.y; }
    constexpr float CQ = 0.14724448646421766f;
#pragma unroll
    for (int d0 = 0; d0 < 6; ++d0) { u32x4 w; w.x = cvt_pk(v[d0][0] * CQ, v[d0][1] * CQ); w.y = cvt_pk(v[d0][2] * CQ, v[d0][3] * CQ); w.z = cvt_pk(v[d0][4] * CQ, v[d0][5] * CQ); w.w = cvt_pk(v[d0][6] * CQ, v[d0][7] * CQ);
      qr[d0] = __builtin_bit_cast(bf16x8, w); }
  }
  const int kq = lane >> 4, kc0 = (lane & 15) ^ kq, kc1 = (lane & 15) ^ (4 + kq);
  const char* ksrc0 = (const char*)Kh + (size_t)(8 * wid + kq) * (LDK * 2) + (kc0 > 11 ? 11 : kc0) * 16;
  const char* ksrc1 = (const char*)Kh + (size_t)(8 * wid + 4 + kq) * (LDK * 2) + (kc1 > 11 ? 11 : kc1) * 16;
  const int vkk = 8 * wid + ((lane & 31) >> 2), vk = (vkk & ~0xC) | ((vkk & 4) << 1) | ((vkk & 8) >> 1);
  const char* vsrc = (const char*)Vh + (size_t)vk * (LDV * 2) + (32 * (lane >> 5) + 8 * (lane & 3)) * 2;
  const unsigned kdst = lds0 + LDS_KR + wid * 2048, vdst = lds0 + LDS_VR + wid * 1024;
#define DMA_K(t, slot) do { const size_t o_ = (size_t)(t) * (KVBLK * LDK * 2); const unsigned d_ = (unsigned)__builtin_amdgcn_readfirstlane(kdst + (slot) * KSLOT); glds16(ksrc0 + o_, d_); glds16(ksrc1 + o_, d_ + 1024u); } while (0)
#define DMA_V(t, slot) glds16(vsrc + (size_t)(t) * (KVBLK * LDV * 2), (unsigned)__builtin_amdgcn_readfirstlane(vdst + (slot) * VSLOT))
#define RESC(a) do { if (__any((a) < 1.f)) { if (hi == 0) al_l[r32] = (a); asm volatile("s_waitcnt lgkmcnt(0)" ::: "memory"); \
    _Pragma("unroll") for (int d = 0; d < 2; ++d) _Pragma("unroll") for (int r = 0; r < 16; ++r) o[d][r] *= al_l[crow(r, hi)]; } } while (0)
  const int vb0 = (int)lds0 + LDS_VR + v_rd_base(lane);
  f32x16 pA0, pA1, pB0, pB1; float alA, alB; bf16x8 pa0, pa1, pa2, pa3; const int NT = seq / KVBLK;
  DMA_K(0, 0); DMA_K(1, 1); DMA_V(0, 0);
  WAIT_BAR(0);
#define STEP(C0, C1, alC, P0, P1, alP, t) do { \
    SBAR(); qkt(C0, C1, lds + LDS_KR + ((t) & 3) * KSLOT, qr, negm, r32, hi); \
    finishSM(P0, P1, alP, l_reg, pa0, pa1, pa2, pa3); SBAR(); \
    pv2(o, vb0 + (((t) - 1) & 3) * VSLOT, pa0, pa1, pa2, pa3); partialSM<false>(C0, C1, m_reg, negm, alC); \
    RESC(alC); } while (0)
  DMA_K(2, 2); DMA_K(3, 3); DMA_V(1, 1); DMA_V(2, 2);
  qkt(pA0, pA1, lds + LDS_KR, qr, negm, r32, hi); partialSM<true>(pA0, pA1, m_reg, negm, alA);
  STEP(pB0, pB1, alB, pA0, pA1, alA, 1);
  WAIT_BAR(0);
  for (int t = 2; t < NT; t += 2) {
    if (t + 2 < NT) { DMA_K(t + 2, (t + 2) & 3); DMA_K(t + 3, (t + 3) & 3); }
    if (t + 1 < NT) DMA_V(t + 1, (t + 1) & 3); if (t + 2 < NT) DMA_V(t + 2, (t + 2) & 3);
    STEP(pA0, pA1, alA, pB0, pB1, alB, t);
    STEP(pB0, pB1, alB, pA0, pA1, alA, t + 1);
    WAIT_BAR(0);
  }
  finishSM(pB0, pB1, alB, l_reg, pa0, pa1, pa2, pa3); SBAR();
  pv2(o, vb0 + ((NT - 1) & 3) * VSLOT, pa0, pa1, pa2, pa3);
  if (hi == 0) li_l[r32] = l_reg; asm volatile("s_waitcnt lgkmcnt(0)" ::: "memory");
  float rli[16];
#pragma unroll
  for (int r = 0; r < 16; ++r) rli[r] = __builtin_amdgcn_rcpf(li_l[crow(r, hi)]);
  bf16_t* Ow = Ob + (long)(wid * QBLK) * LDO;
#pragma unroll
  for (int r = 0; r < 16; ++r) { const int orow = crow(r, hi);
#pragma unroll
    for (int d0 = 0; d0 < 2; ++d0) Ow[(long)orow * LDO + d0 * 32 + r32] = (bf16_t)(cvt_pk(o[d0][r] * rli[r], 0.f) & 0xffffu); }
  asm volatile("s_waitcnt lgkmcnt(0)\n\ts_barrier" ::: "memory");
#undef DMA_K
#undef DMA_V
#undef RESC
#undef STEP
}
#undef SBAR
}

__device__ __forceinline__ void attention_phase(const Args& a, unsigned char* lds, const int wv, int l) {
    unsigned char* ws = a.ws; const float* gq = a.in[8] + l * DQK; const float2* rt = (const float2*)(ws + WS_ROPE);
    const bf16_t* Qb = (const bf16_t*)(ws + WS_QB); const bf16_t* Kb = (const bf16_t*)(ws + WS_KB); const bf16_t* KV = (const bf16_t*)(ws + WS_KVRAW); bf16_t* FA = (bf16_t*)(ws + WS_FA);
    const int G = lgdim();
    for (int u = lbid(); u < 512; u += G) { const int h = u & 7, qb = u >> 3; const size_t t0 = TP;
        att::attn_unit(Qb + (t0 + (size_t)qb * 256) * 768 + h * 96, Kb + t0 * 768 + h * 96, KV + t0 * 1024 + h * 128 + 64, FA + (t0 + (size_t)qb * 256) * 1024 + 512 + h * 64, 16384, (char*)lds, wv, gq, rt, qb * 256); }
    for (int u = lbid() * 8; u < 2048; u += G * 8)
        for (int qb = 0; qb < 8; ++qb) { const int bh = u >> 3, b = bh >> 3, h = bh & 7; const size_t t0 = (size_t)b * 2048;
            att::attn_unit(Qb + (t0 + (size_t)qb * 256) * 768 + h * 96, Kb + t0 * 768 + h * 96, KV + t0 * 1024 + h * 128 + 64, FA + (t0 + (size_t)qb * 256) * 1024 + 512 + h * 64, 2048, (char*)lds, wv, gq, rt, qb * 256); }
    __syncthreads();
}


typedef const __attribute__((address_space(4))) Args* KArgs;
extern __shared__ __attribute__((aligned(16))) unsigned char lds_dyn[];

#define XB_TMO      128
#define XB_XCNT(j)  (256  + 64 * (j))
#define XB_XSUB(j)  (1280 + 64 * (j))
#define XB_XGEN(j)  (2304 + 64 * (j))
#define XB_TOP      3328
#define XB_TOPGEN   3392
#define XCD_BAR_WORDS 3456
#define XB_SPIN_CAP (1u << 18)
__device__ __forceinline__ unsigned xb_ld(unsigned* p)              { return __hip_atomic_load(p, __ATOMIC_RELAXED, __HIP_MEMORY_SCOPE_AGENT); }
__device__ __forceinline__ unsigned xb_add(unsigned* p, unsigned v) { return __hip_atomic_fetch_add(p, v, __ATOMIC_RELAXED, __HIP_MEMORY_SCOPE_AGENT); }
__device__ __forceinline__ unsigned xb_xcc_id() { return (unsigned)__builtin_amdgcn_s_getreg((3 << 11) | 20) & 0xFu; }
#define XB_SPIN(cond, bar) do { unsigned _sp = 0; while (cond) { __builtin_amdgcn_s_sleep(1); \
    if ((++_sp & 255u) == 0u) { if (xb_ld(&(bar)[XB_TMO])) break; if (_sp > XB_SPIN_CAP) { atomicAdd(&(bar)[XB_TMO], 1u); break; } } } } while (0)
__device__ __forceinline__ void xcd_barrier_complete(unsigned* bar, unsigned x, unsigned& nloc, unsigned& nx) {
    const unsigned G = gridDim.x * gridDim.y * gridDim.z;
    unsigned sum, cnt, mine, sp = 0u;
    for (;;) {
        sum = 0u; cnt = 0u; mine = 0u;
#pragma unroll
        for (unsigned j = 0; j < 16; ++j) { const unsigned c = xb_ld(&bar[XB_XCNT(j)]); sum += c; cnt += (c > 0u) ? 1u : 0u; mine = (j == x) ? c : mine; }
        if (sum == G) break;
        __builtin_amdgcn_s_sleep(1);
        if ((++sp & 255u) == 0u) { if (xb_ld(&bar[XB_TMO])) break; if (sp > XB_SPIN_CAP) { atomicAdd(&bar[XB_TMO], 1u); break; } }
    }
    nloc = mine > 0u ? mine : 1u; nx = cnt > 0u ? cnt : 1u;
}
__device__ __forceinline__ void grid_barrier(unsigned* bar, volatile LAS unsigned* st, const int wv) {
    asm volatile("s_waitcnt vmcnt(0)" ::: "memory");
    __syncthreads();
    if (ltid(wv) == 0) {
        const unsigned x = xb_xcc_id();
        __builtin_amdgcn_s_waitcnt(0);
        unsigned nloc = st[0], nx = st[1];
        if (nloc == 0u) { xcd_barrier_complete(bar, x, nloc, nx); st[0] = nloc; st[1] = nx; }
        const unsigned old = xb_add(&bar[XB_XSUB(x)], 1u);
        const unsigned gen = old / nloc;
        if (old + 1u == (gen + 1u) * nloc) {
            __builtin_amdgcn_fence(__ATOMIC_RELEASE, "agent");
            asm volatile("s_waitcnt vmcnt(0)" ::: "memory");
            const unsigned og = xb_add(&bar[XB_TOP], 1u);
            const unsigned tg = og / nx;
            if (og + 1u == (tg + 1u) * nx) xb_add(&bar[XB_TOPGEN], 1u);
            else XB_SPIN(xb_ld(&bar[XB_TOPGEN]) == tg, bar);
            __builtin_amdgcn_fence(__ATOMIC_ACQUIRE, "agent");
            xb_add(&bar[XB_XGEN(x)], 1u);
            asm volatile("s_waitcnt vmcnt(0)" ::: "memory");
        } else {
            XB_SPIN(xb_ld(&bar[XB_XGEN(x)]) == gen, bar);
            __builtin_amdgcn_fence(__ATOMIC_ACQUIRE, "agent");
            asm volatile("s_waitcnt vmcnt(0)" ::: "memory");
        }
    }
    __syncthreads();
}

constexpr int LDS_BYTES = 131072 + 64;
constexpr int N_PHASES = 17;
#ifndef PH_MASK
#define PH_MASK 0xfff
#endif
#define EN(k) (((PH_MASK) >> (k)) & 1)
#ifndef PROBE_PH
#define PROBE_PH -1
#endif
#ifndef PROBE_OFF0
#define PROBE_OFF0 230
#endif
#ifndef PROBE_OFF1
#define PROBE_OFF1 -1
#endif
#ifndef PROBE_N1
#define PROBE_N1 0
#endif
#ifndef MK_PER_PHASE
#define MK_PER_PHASE 0
#endif
template <class Epi> __device__ __forceinline__ void run_gemm(unsigned char* lds, const bf16_t* A, int lda, const bf16_t* Bt, int ldb, int N, int K, const Epi& E, const int wv, const int ablk = 0) {
    asm volatile("" : "+s"(K));
    pg8::Gemm g{A, Bt, T, N, K, lda, ldb, ablk}; pg8::StaticOrder S; S.init(T, N, lgdim(), lbid());
    pg8::gemm_phase<Epi, pg8::StaticOrder, true, true>((LAS unsigned char*)lds, g, S, E, wv);
}
__device__ __forceinline__ void do_phase(const Args& a_, const int ph, unsigned char* lds, const int wv) {
#if defined(__HIP_DEVICE_COMPILE__)
        const __attribute__((address_space(4))) Args* ap = (const __attribute__((address_space(4))) Args*)__builtin_amdgcn_kernarg_segment_ptr(); asm volatile("" : "+s"(ap));
        const Args a = *ap;
#else
        const Args a = a_;
#endif
        unsigned char* ws = a.ws;
        u64* ssq_all = (u64*)(ws + WS_SSQ);
        bf16_t* AB = (bf16_t*)(ws + WS_AB);
#if PROBE_PH >= 0
        if (ph == 100) {
            const bf16_t* b0 = (const bf16_t*)(ws + PROBE_OFF0 * MiB); const bf16_t* b1 = (const bf16_t*)(ws + PROBE_OFF1 * MiB);
            for (size_t i = (size_t)lbid() * 512 + ltid(wv); i < (size_t)T * DM; i += (size_t)lgdim() * 512) {
                float v = __uint_as_float((unsigned)b0[i] << 16); if (PROBE_OFF1 >= 0 && i < (size_t)PROBE_N1) v += __uint_as_float((unsigned)b1[i] << 16);
                a.out[i] = v; }
        } else
#endif
        if (ph == 0) { if (EN(9)) p0_prologue(a, lds, wv); }
        else {
            const int l = (ph - 1) / 8, j0 = (ph - 1) % 8, j = j0 < 4 ? j0 : j0 + 1;
            unsigned char* wl = ws + WS_W + (size_t)l * W_LAYER;
            u64* ssq_x = ssq_all + (size_t)(l * 4 + 0) * T; u64* ssq_q = ssq_all + (size_t)(l * 4 + 1) * T; u64* ssq_kv = ssq_all + (size_t)(l * 4 + 2) * T; u64* ssq_h = ssq_all + (size_t)(l * 4 + 3) * T;
            if (j == 0 && EN(0)) {
                EpiIn E{(bf16_t*)(ws + WS_VC), (bf16_t*)(ws + WS_CQ), (bf16_t*)(ws + WS_CKV), ssq_x, ssq_q, ssq_kv, (bf16_t*)a.out};
                run_gemm(lds, AB, 1024, (const bf16_t*)(wl + WO_IN1), 1024, 3584, 1024, E, wv);
            } else if (j == 1 && EN(1)) {
                { EpiRowScale<0> E{(bf16_t*)(ws + WS_QB), 768, ssq_q, 1.0f / 256.0f}; run_gemm(lds, (const bf16_t*)(ws + WS_CQ), 256, (const bf16_t*)(wl + WO_UQ), 256, 768, 256, E, wv); }
                { EpiRowScale<3> E{(bf16_t*)(ws + WS_KVRAW), 1024, ssq_kv, 1.0f / 128.0f}; run_gemm(lds, (const bf16_t*)(ws + WS_CKV), 256, (const bf16_t*)(wl + WO_UKV), 128, 1024, 128, E, wv); }
            } else if (j == 2) {
                if (EN(2)) finalize_qk(a, l, wv); if (EN(10)) fourier_stage1(a, lds, wv);
            } else if (j == 3) {
                if (EN(3)) attention_phase(a, lds, wv, l); if (EN(11)) fourier_stage2(a, lds, wv);
            } else if (j == 4 && EN(4)) {
                EpiRowScale<1> E{(bf16_t*)(ws + WS_GG), 2048, ssq_x, 1.0f / 1024.0f};
                run_gemm(lds, AB, 1024, (const bf16_t*)(wl + WO_G), 1024, 2048, 1024, E, wv);
            } else if (j == 5 && EN(5)) {
                { EpiMixK E{(bf16_t*)(ws + WS_MB), (const bf16_t*)a.out}; run_gemm(lds, (const bf16_t*)(ws + WS_FA), 1024, (const bf16_t*)(wl + WO_OF), 1024, 1024, 1024, E, wv); }
            } else if (j == 6 && EN(6)) {
                if (l == 0) { EpiResid<false, true, false> E{a.in[0], a.in[1], nullptr, AB, ssq_h}; run_gemm(lds, (const bf16_t*)(ws + WS_MB), 1024, (const bf16_t*)(wl + WO_OUT), 1024, 1024, 1024, E, wv, 1); }
                else { EpiResid<true, true, false> E{nullptr, nullptr, nullptr, AB, ssq_h}; run_gemm(lds, (const bf16_t*)(ws + WS_MB), 1024, (const bf16_t*)(wl + WO_OUT), 1024, 1024, 1024, E, wv, 1); }
            } else if (j == 7 && EN(7)) {
                EpiRowScale<2, true> E{(bf16_t*)(ws + WS_UB), 4096, ssq_h, 1.0f / 1024.0f};
                run_gemm(lds, AB, 1024, (const bf16_t*)(wl + WO_UP), 1024, 4096, 1024, E, wv);
            } else if (j == 8 && EN(8)) {
                if (l == 0) { EpiResid<true, true, false> E{nullptr, nullptr, nullptr, AB, ssq_all + (size_t)4 * T}; run_gemm(lds, (const bf16_t*)(ws + WS_UB), 4096, (const bf16_t*)(wl + WO_DN), 4096, 1024, 4096, E, wv, 1); }
                else { EpiResid<true, false, true> E{nullptr, nullptr, a.out, AB, nullptr}; run_gemm(lds, (const bf16_t*)(ws + WS_UB), 4096, (const bf16_t*)(wl + WO_DN), 4096, 1024, 4096, E, wv, 1); }
            }
        }
}
__global__ void __launch_bounds__(512, 2) mega_fwd(Args a_) {
    unsigned char* lds = lds_dyn;
    cg::grid_group grid = cg::this_grid();
    const int ph_lo = a_.ph_lo, ph_hi = a_.ph_hi;
    const int wv = __builtin_amdgcn_readfirstlane((int)threadIdx.x >> 6);
    unsigned* bar = (unsigned*)(a_.ws + WS_BAR);
    volatile LAS unsigned* bst = (volatile LAS unsigned*)((LAS unsigned char*)lds + 131072);
    if (threadIdx.x == 0) { bst[0] = 0u; bst[1] = 0u; (void)xb_add(&bar[XB_XCNT(xb_xcc_id())], 1u); }
    __syncthreads();
    if (ph_hi < 0) grid.sync();
#define STEP(k) if (ph_lo <= (k) && (k) < ph_hi) { do_phase(a_, (k), lds, wv); if ((k) + 1 < ph_hi) grid_barrier(bar, bst, wv); }
    STEP(0) STEP(1) STEP(2) STEP(3) STEP(4) STEP(5) STEP(6) STEP(7) STEP(8) STEP(9) STEP(10) STEP(11) STEP(12) STEP(13) STEP(14) STEP(15) STEP(16)
#if PROBE_PH >= 0
    STEP(100)
#endif
#undef STEP
}

extern "C" void kernel_launch(void* const* d_in, const int* in_sizes, int n_in, void* d_out, int out_size, void* d_ws, size_t ws_size, hipStream_t stream) {
    static int grid = 0;
    if (grid == 0) {
        if (n_in != 16 || out_size != T * DM || ws_size < WS_END) { fprintf(stderr, "kernel_launch: unexpected shapes (n_in %d out %d ws %zu, need ws >= %zu)\n", n_in, out_size, ws_size, (size_t)WS_END); grid = -1; return; }
        int dev = 0, cus = 0, per_cu = 0;
        if (hipGetDevice(&dev) != hipSuccess || hipDeviceGetAttribute(&cus, hipDeviceAttributeMultiprocessorCount, dev) != hipSuccess) { fprintf(stderr, "kernel_launch: device query failed\n"); grid = -1; return; }
        if (hipFuncSetAttribute((const void*)mega_fwd, hipFuncAttributeMaxDynamicSharedMemorySize, LDS_BYTES) != hipSuccess) { fprintf(stderr, "kernel_launch: hipFuncSetAttribute failed\n"); grid = -1; return; }
        if (hipOccupancyMaxActiveBlocksPerMultiprocessor(&per_cu, (const void*)mega_fwd, 512, LDS_BYTES) != hipSuccess || per_cu < 1) { fprintf(stderr, "kernel_launch: occupancy query says %d\n", per_cu); per_cu = 1; }
        (void)hipGetLastError();
        grid = cus;
        if (grid % 8 != 0 || grid <= 0) { fprintf(stderr, "kernel_launch: unexpected CU count %d\n", cus); grid = -1; return; }
    }
    if (grid < 0) return;
    if (hipMemsetAsync((char*)d_ws + WS_BAR, 0, 16384, stream) != hipSuccess) { fprintf(stderr, "kernel_launch: memset failed\n"); return; }
    Args a{};
    for (int i = 0; i < 16; ++i) a.in[i] = (const float*)d_in[i];
    a.out = (float*)d_out; a.ws = (unsigned char*)d_ws;
#if MK_PER_PHASE
    for (int ph = 0; ph < N_PHASES; ++ph) { if (PROBE_PH >= 0 && ph > PROBE_PH) break; a.ph_lo = ph; a.ph_hi = ph + 1; hipLaunchKernelGGL(mega_fwd, dim3(grid), dim3(512), LDS_BYTES, stream, a); }
    if (PROBE_PH >= 0) { a.ph_lo = 100; a.ph_hi = 101; hipLaunchKernelGGL(mega_fwd, dim3(grid), dim3(512), LDS_BYTES, stream, a); }
#else
    a.ph_lo = 0; a.ph_hi = N_PHASES;
    void* args[] = {&a};
    hipError_t e = hipLaunchCooperativeKernel((const void*)mega_fwd, dim3(grid), dim3(512), args, LDS_BYTES, stream);
    if (e != hipSuccess) fprintf(stderr, "cooperative launch failed: %s (grid %d)\n", hipGetErrorString(e), grid);
#endif
}
```
